# Optimizing an MI355X kernel written in HIP

```python
import math
import jax
import jax.numpy as jnp
from jax import lax
import numpy as np

D_MODEL = 1024
BATCH = 4
SEQ = 8192
DEPTH = 2

N_A_LAYERS = DEPTH // 2
N_B_LAYERS = DEPTH - N_A_LAYERS
PLE_DIM = 256
D_FF = 2816
EPS = 1e-6
N_SUBNORMS = 8

MLSTM_HEADS = 4
MLSTM_DV = D_MODEL // MLSTM_HEADS
MLSTM_DK = MLSTM_DV // 2
MLSTM_CHUNK = 128
MLSTM_QK_W = MLSTM_HEADS * MLSTM_DK
MLSTM_IN = 2 * MLSTM_QK_W + 2 * D_MODEL + 2 * MLSTM_HEADS

DIFF_HEAD_DIM = 64
DIFF_HEADS = D_MODEL // (2 * DIFF_HEAD_DIM)
Q_BLOCK = 128

kernel_name = "yoco_mlstm_diffattn_macaron_block"


def rms_norm(x, g):
    xf = x.astype(jnp.float32)
    y = xf * lax.rsqrt(jnp.mean(xf * xf, axis=-1, keepdims=True) + EPS)
    return (y * g.astype(jnp.float32)).astype(x.dtype)


def swiglu(x, w_in, w_out):
    gate, up = jnp.split(x @ w_in, 2, axis=-1)
    return (jax.nn.silu(gate) * up) @ w_out


def mlstm_chunkwise(q, k, v, log_i, log_f):
    B, H, S, DK = q.shape
    DV = v.shape[-1]
    L = MLSTM_CHUNK
    NC = S // L
    q, k, v = (t.astype(jnp.float32) for t in (q, k, v))

    def chunks(t):
        return jnp.moveaxis(t.reshape(B, H, NC, L, *t.shape[3:]), 2, 0)

    xs = tuple(chunks(t) for t in (q, k, v, log_i, log_f))
    causal = jnp.tril(jnp.ones((L, L), dtype=bool))

    def step(carry, inp):
        C, n, m = carry
        qj, kj, vj, li, lf = inp
        b = jnp.cumsum(lf, axis=-1)
        d = b[..., :, None] - b[..., None, :] + li[..., None, :]
        d = jnp.where(causal, d, -jnp.inf)
        inter = b + m[..., None]
        m_t = jnp.maximum(inter, jnp.max(d, axis=-1))
        w = jnp.exp(d - m_t[..., None])
        s_inter = jnp.exp(inter - m_t)
        qk = jnp.einsum('bhtd,bhsd->bhts', qj, kj) * w
        num = (jnp.einsum('bhts,bhsv->bhtv', qk, vj)
               + s_inter[..., None] * jnp.einsum('bhtd,bhdv->bhtv', qj, C))
        den = jnp.sum(qk, axis=-1) + s_inter * jnp.einsum('bhtd,bhd->bht', qj, n)
        h = num / jnp.maximum(jnp.abs(den), jnp.exp(-m_t))[..., None]
        bL = b[..., -1]
        g = bL[..., None] - b + li
        m_new = jnp.maximum(bL + m, jnp.max(g, axis=-1))
        sc = jnp.exp(g - m_new[..., None])
        decay = jnp.exp(bL + m - m_new)
        C_new = decay[..., None, None] * C + jnp.einsum('bhs,bhsd,bhsv->bhdv', sc, kj, vj)
        n_new = decay[..., None] * n + jnp.einsum('bhs,bhsd->bhd', sc, kj)
        return (C_new, n_new, m_new), h

    init = (jnp.zeros((B, H, DK, DV), jnp.float32),
            jnp.zeros((B, H, DK), jnp.float32),
            jnp.full((B, H), -jnp.inf, jnp.float32))
    _, hs = lax.scan(step, init, xs)
    return jnp.moveaxis(hs, 0, 2).reshape(B, H, S, DV)


def mlstm_mixer(x, w_in, b_gates, head_norm, w_out):
    B, S, _ = x.shape
    proj = x @ w_in
    q, k, v, o, gates = jnp.split(
        proj, [MLSTM_QK_W, 2 * MLSTM_QK_W, 2 * MLSTM_QK_W + D_MODEL,
               2 * MLSTM_QK_W + 2 * D_MODEL], axis=-1)

    def heads(t, d):
        return t.reshape(B, S, MLSTM_HEADS, d).transpose(0, 2, 1, 3)

    q = heads(q, MLSTM_DK)
    k = heads(k, MLSTM_DK) * (MLSTM_DK ** -0.5)
    v = heads(v, MLSTM_DV)
    gates = gates.astype(jnp.float32) + b_gates.astype(jnp.float32)
    log_i = gates[..., :MLSTM_HEADS].transpose(0, 2, 1)
    log_f = jax.nn.log_sigmoid(gates[..., MLSTM_HEADS:]).transpose(0, 2, 1)
    h = mlstm_chunkwise(q, k, v, log_i, log_f)
    h = rms_norm(h, head_norm[:, None, :])
    h = h.transpose(0, 2, 1, 3).reshape(B, S, D_MODEL).astype(x.dtype)
    return (jax.nn.sigmoid(o) * h) @ w_out


def shared_kv(x, kv_norm, w_kv):
    B, S, _ = x.shape
    kv = rms_norm(x, kv_norm) @ w_kv
    k, v = jnp.split(kv, 2, axis=-1)
    k = k.reshape(B, S, 2 * DIFF_HEADS, DIFF_HEAD_DIM).transpose(0, 2, 1, 3)
    v = v.reshape(B, S, DIFF_HEADS, 2 * DIFF_HEAD_DIM).transpose(0, 2, 1, 3)
    return k, v


def diff_attention(x, k_sh, v_sh, w_q, lam_vecs, subln, w_out, lam_init):
    B, S, _ = x.shape
    H, DH = DIFF_HEADS, DIFF_HEAD_DIM
    q = (x @ w_q).reshape(B, S, 2 * H, DH).transpose(0, 2, 1, 3) * (DH ** -0.5)
    lv = lam_vecs.astype(jnp.float32)
    lam = jnp.exp(jnp.sum(lv[0] * lv[1])) - jnp.exp(jnp.sum(lv[2] * lv[3])) + lam_init
    nb = S // Q_BLOCK
    qb = jnp.moveaxis(q.reshape(B, 2 * H, nb, Q_BLOCK, DH), 2, 0)
    key_pos = jnp.arange(S)

    def block(args):
        qi, start = args
        s = jnp.einsum('bhqd,bhkd->bhqk', qi, k_sh).astype(jnp.float32)
        qpos = start + jnp.arange(Q_BLOCK)
        s = jnp.where(key_pos[None, :] <= qpos[:, None], s, -jnp.inf)
        a = jax.nn.softmax(s, axis=-1).reshape(B, H, 2, Q_BLOCK, S)
        diff = a[:, :, 0] - lam * a[:, :, 1]
        return jnp.einsum('bhqk,bhkv->bhqv', diff.astype(v_sh.dtype), v_sh)

    o = lax.map(block, (qb, jnp.arange(nb) * Q_BLOCK))
    o = o.transpose(1, 2, 0, 3, 4).reshape(B, H, S, 2 * DH)
    o = rms_norm(o, subln) * (1.0 - lam_init)
    o = o.transpose(0, 2, 1, 3).reshape(B, S, D_MODEL).astype(x.dtype)
    return o @ w_out


def setup_inputs(seed: int = 0) -> dict:
    key = jax.random.key(seed)
    ks = jax.random.split(key, 20)
    f32 = jnp.float32

    def nrm(k, shape, fan_in):
        return jax.random.normal(k, shape, f32) * (fan_in ** -0.5)

    def gain(k, shape):
        return 1.0 + 0.05 * jax.random.normal(k, shape, f32)

    f_bias = jnp.linspace(3.0, 6.0, MLSTM_HEADS, dtype=f32)
    b_gates = jnp.concatenate(
        [0.1 * jax.random.normal(ks[8], (N_A_LAYERS, MLSTM_HEADS), f32),
         f_bias[None, :] + 0.1 * jax.random.normal(ks[9], (N_A_LAYERS, MLSTM_HEADS), f32)], axis=-1)
    return {
        "x": jax.random.normal(ks[0], (BATCH, SEQ, D_MODEL), f32),
        "p": jax.random.normal(ks[1], (DEPTH, BATCH, SEQ, PLE_DIM), f32),
        "norm_g": gain(ks[2], (DEPTH, N_SUBNORMS, D_MODEL)),
        "w_ffn_in": nrm(ks[3], (DEPTH, 2, D_MODEL, 2 * D_FF), D_MODEL),
        "w_ffn_out": nrm(ks[4], (DEPTH, 2, D_FF, D_MODEL), D_FF),
        "w_ple_proj": nrm(ks[5], (DEPTH, PLE_DIM, D_MODEL), PLE_DIM),
        "w_ple_gate": nrm(ks[6], (DEPTH, D_MODEL, D_MODEL), D_MODEL),
        "mlstm_w_in": nrm(ks[7], (N_A_LAYERS, D_MODEL, MLSTM_IN), D_MODEL),
        "mlstm_b_gates": b_gates,
        "mlstm_head_norm": gain(ks[10], (N_A_LAYERS, MLSTM_HEADS, MLSTM_DV)),
        "mlstm_w_out": nrm(ks[11], (N_A_LAYERS, D_MODEL, D_MODEL), D_MODEL),
        "kv_norm": gain(ks[12], (D_MODEL,)),
        "w_kv": nrm(ks[13], (D_MODEL, 2 * D_MODEL), D_MODEL),
        "diff_w_q": nrm(ks[14], (N_B_LAYERS, D_MODEL, D_MODEL), D_MODEL),
        "diff_lambda": 0.1 * jax.random.normal(ks[15], (N_B_LAYERS, 4, DIFF_HEAD_DIM), f32),
        "diff_subln": gain(ks[16], (N_B_LAYERS, 2 * DIFF_HEAD_DIM)),
        "diff_w_out": nrm(ks[17], (N_B_LAYERS, D_MODEL, D_MODEL), D_MODEL),
    }


def reference(x, p, norm_g, w_ffn_in, w_ffn_out, w_ple_proj, w_ple_gate,
              mlstm_w_in, mlstm_b_gates, mlstm_head_norm, mlstm_w_out,
              kv_norm, w_kv, diff_w_q, diff_lambda, diff_subln, diff_w_out):
    k_sh = None
    v_sh = None
    for layer in range(DEPTH):
        g = norm_g[layer]
        h = swiglu(rms_norm(x, g[0]), w_ffn_in[layer, 0], w_ffn_out[layer, 0])
        x = x + 0.5 * rms_norm(h, g[1])
        h = rms_norm(x, g[2])
        if layer < N_A_LAYERS:
            h = mlstm_mixer(h, mlstm_w_in[layer], mlstm_b_gates[layer],
                            mlstm_head_norm[layer], mlstm_w_out[layer])
        else:
            j = layer - N_A_LAYERS
            lam_init = 0.8 - 0.6 * math.exp(-0.3 * layer)
            h = diff_attention(h, k_sh, v_sh, diff_w_q[j], diff_lambda[j],
                               diff_subln[j], diff_w_out[j], lam_init)
        x = x + rms_norm(h, g[3])
        h = swiglu(rms_norm(x, g[4]), w_ffn_in[layer, 1], w_ffn_out[layer, 1])
        x = x + 0.5 * rms_norm(h, g[5])
        gate = jax.nn.sigmoid(rms_norm(x, g[6]) @ w_ple_gate[layer])
        e = p[layer].astype(x.dtype) @ w_ple_proj[layer]
        x = x + rms_norm(e * gate, g[7])
        if layer == N_A_LAYERS - 1:
            k_sh, v_sh = shared_kv(x, kv_norm, w_kv)
    return x
```

```cpp
#include <hip/hip_runtime.h>
#include <cstdio>
#include <cstdint>
namespace pg8 {
#define PG8_LAS __attribute__((address_space(3)))
typedef unsigned short bf16_t;
typedef short bf16x8 __attribute__((ext_vector_type(8)));
typedef float f32x4 __attribute__((ext_vector_type(4)));
typedef unsigned u32x4 __attribute__((ext_vector_type(4)));
constexpr int BM = 256, BK = 64, HALF = 128, HTB = HALF * BK * 2  , STAGE_BYTES = 8 * HTB, NXCD = 8, WGM = 8;

__host__ __device__ __forceinline__ int lds_byte(int r, int c) { const int st = (r >> 4) * 2 + (c >> 5), rr = r & 15, cc = c & 31, ob = rr * 64 + cc * 2; return st * 1024 + (ob ^ (((ob >> 9) & 1) << 5)); }
__host__ __device__ __forceinline__ void stage_rc(int b, int& R, int& C) { const int st = b / 1024, sb = b % 1024, swz = sb ^ (((sb >> 9) & 1) << 5); R = (st >> 1) * 16 + swz / 64; C = (st & 1) * 32 + (swz % 64) / 2; }
__host__ __device__ __forceinline__ int perm32(int rho) { const int n = rho >> 4, i = rho & 15; return 8 * (i >> 2) + 4 * n + (i & 3); }

struct Unit { int pm, pn; };
struct Gemm { const bf16_t* A; const bf16_t* Bt; int M, N, K; };

struct StaticOrder {
    int nM, nN, nwg, G, c;
    __host__ __device__ void init(int M, int N, int G_, int c_) { nM = M / BM; nN = N / BM; nwg = nM * nN; G = G_; c = c_; }
    __host__ __device__ bool next(int i, Unit& u) const {
        const long L = (long)i * G + c; if (L >= nwg) return false;
        int wgid = (int)L; { const int q = nwg / NXCD, r = nwg % NXCD, xcd = wgid % NXCD, off = wgid / NXCD; wgid = (xcd < r ? xcd * (q + 1) : r * (q + 1) + (xcd - r) * q) + off; }
        const int nig = WGM * nN, gid = wgid / nig, fm = gid * WGM, gsz = (nM - fm) < WGM ? (nM - fm) : WGM;
        u.pm = fm + ((wgid % nig) % gsz); u.pn = (wgid % nig) / gsz; return true;
    }
    __device__ __forceinline__ void a_ready(const Unit&) const {}
    __device__ __forceinline__ void done(const Unit&) const {}
};

typedef float f32x2cv __attribute__((ext_vector_type(2))); typedef __bf16 bf16x2cv __attribute__((ext_vector_type(2)));
__device__ __forceinline__ unsigned cvt_pk_bf16(float lo, float hi) { f32x2cv v = {lo, hi}; bf16x2cv b = __builtin_convertvector(v, bf16x2cv); return __builtin_bit_cast(unsigned, b); }
typedef float f32x2 __attribute__((ext_vector_type(2)));
__device__ __forceinline__ float bf2f(unsigned short b) { return __uint_as_float(((unsigned)b) << 16); }
__device__ __forceinline__ float sigm(float x) { return __builtin_amdgcn_rcpf(1.f + __expf(-x)); }
template <int MODE, bool RS = false> struct EpiX {
    static constexpr bool PERM = true, AFTER_DRAIN = false;
    bf16_t* O; int ldc; int split_cols; size_t split_stride; int sc_lo, sc_hi; float scale; const float* rs;
    __device__ __forceinline__ void operator()(const f32x4 (&acc)[2][2][4][2], const Unit& u, int wr, int wc, int fr, int fq) const {
        typedef __attribute__((address_space(1))) bf16_t gbf16_t;
        gbf16_t* O_ = (gbf16_t*)O; asm volatile("" : "+s"(O_));
        const __attribute__((address_space(1))) float* rs_ = (const __attribute__((address_space(1))) float*)rs; if constexpr (RS) asm volatile("" : "+s"(rs_));
        const int row0 = u.pm * BM + wr * 64 + fr;
        if constexpr (MODE == 1) {
            const int col0 = u.pn * HALF + wc * 32 + 8 * fq;
#pragma unroll
            for (int ai = 0; ai < 2; ++ai)
#pragma unroll
                for (int m = 0; m < 4; ++m) { gbf16_t* rowp = O_ + (size_t)(row0 + ai * HALF + m * 16) * ldc + col0;
                    float rr = 1.f; if constexpr (RS) rr = rs_[row0 + ai * HALF + m * 16];
                    f32x4 g0 = acc[ai][0][m][0] * rr, g1 = acc[ai][0][m][1] * rr; const f32x4 u0 = acc[ai][1][m][0] * rr, u1 = acc[ai][1][m][1] * rr;
#pragma unroll
                    for (int e = 0; e < 4; ++e) { g0[e] = g0[e] * sigm(g0[e]) * u0[e]; g1[e] = g1[e] * sigm(g1[e]) * u1[e]; }
                    u32x4 w; w.x = cvt_pk_bf16(g0[0], g0[1]); w.y = cvt_pk_bf16(g0[2], g0[3]); w.z = cvt_pk_bf16(g1[0], g1[1]); w.w = cvt_pk_bf16(g1[2], g1[3]);
                    *(__attribute__((address_space(1))) u32x4*)rowp = w; }
        } else {
            int colt = u.pn * BM; gbf16_t* base = O_;
            const float sc = (colt >= sc_lo && colt < sc_hi) ? scale : 1.f;
            if (split_cols) { const int t = colt / split_cols; base += (size_t)t * split_stride; colt -= t * split_cols; }
            const int col0 = colt + wc * 32 + 8 * fq;
#pragma unroll
            for (int ai = 0; ai < 2; ++ai)
#pragma unroll
                for (int m = 0; m < 4; ++m) { gbf16_t* rowp = base + (size_t)(row0 + ai * HALF + m * 16) * ldc + col0;
                    float rr = sc; if constexpr (RS) rr = sc * rs_[row0 + ai * HALF + m * 16];
#pragma unroll
                    for (int bj = 0; bj < 2; ++bj) { f32x4 v0 = acc[ai][bj][m][0] * rr, v1 = acc[ai][bj][m][1] * rr;
                        if constexpr (MODE == 2) {
#pragma unroll
                            for (int e = 0; e < 4; ++e) { v0[e] = sigm(v0[e]); v1[e] = sigm(v1[e]); } }
                        if constexpr (MODE == 3) { const u32x4 o = *(const __attribute__((address_space(1))) u32x4*)(rowp + bj * HALF);
                            v0[0] *= bf2f((unsigned short)(o.x & 0xffffu)); v0[1] *= bf2f((unsigned short)(o.x >> 16)); v0[2] *= bf2f((unsigned short)(o.y & 0xffffu)); v0[3] *= bf2f((unsigned short)(o.y >> 16));
                            v1[0] *= bf2f((unsigned short)(o.z & 0xffffu)); v1[1] *= bf2f((unsigned short)(o.z >> 16)); v1[2] *= bf2f((unsigned short)(o.w & 0xffffu)); v1[3] *= bf2f((unsigned short)(o.w >> 16)); }
                        u32x4 w; w.x = cvt_pk_bf16(v0[0], v0[1]); w.y = cvt_pk_bf16(v0[2], v0[3]); w.z = cvt_pk_bf16(v1[0], v1[1]); w.w = cvt_pk_bf16(v1[2], v1[3]);
                        *(__attribute__((address_space(1))) u32x4*)(rowp + bj * HALF) = w; } }
        }
    }
};
template <class Epi, class Sched, bool ALIGN_EPI = false, bool SP2 = false>
__device__ __forceinline__ void gemm_phase(PG8_LAS unsigned char* lds, const Gemm g, const Sched& S, const Epi& E) {
    int tid_ = threadIdx.x; asm volatile("" : "+v"(tid_));
    const char* gA_ = (const char*)g.A; const char* gB_ = (const char*)g.Bt; asm volatile("" : "+s"(gA_), "+s"(gB_));
    const int tid = tid_, wid = __builtin_amdgcn_readfirstlane(tid >> 6), lane = tid & 63, wr = wid >> 2, wc = wid & 3, fr = lane & 15, fq = lane >> 4;
    const int K = g.K, nt = K / BK;
    unsigned voffA[2], voffB[2];
#pragma unroll
    for (int i = 0; i < 2; ++i) { int R, C; stage_rc(tid * 16 + i * 8192, R, C); const int Rb = Epi::PERM ? ((R & ~31) + perm32(R & 31)) : R;
        voffA[i] = (unsigned)(R * K + C) * 2u; voffB[i] = (unsigned)(Rb * K + C) * 2u; }
    const size_t kstep = (size_t)(BK * 2);
    const size_t hstep = (size_t)HALF * K * 2;
    const size_t tstep = 2 * hstep;
    const unsigned ldsw = (unsigned)wid * 1024u;
    const int aoff = lds_byte(wr * 64 + fr, fq * 8), boff = lds_byte(wc * 32 + fr, fq * 8);
#define PG8_SA(b, h) (((b) * 2 + (h)) * HTB)
#define PG8_SB(b, h) ((4 + (b) * 2 + (h)) * HTB)
#define PG8_STAGE(bufoff, gbase, voff) do { _Pragma("unroll") for (int _i = 0; _i < 2; ++_i) \
        __builtin_amdgcn_global_load_lds((const unsigned*)((const char*)(gbase) + (voff)[_i]), (PG8_LAS unsigned*)(lds + (bufoff) + ldsw + _i * 8192), 16, 0, 0); } while (0)
#define PG8_LDA(dst, b, h) do { _Pragma("unroll") for (int m = 0; m < 4; ++m) _Pragma("unroll") for (int k = 0; k < 2; ++k) dst[m][k] = *(const PG8_LAS bf16x8*)(lds + PG8_SA(b, h) + aoff + m * 2048 + k * 1024); } while (0)
#define PG8_LDB(dst, b, h) do { _Pragma("unroll") for (int n = 0; n < 2; ++n) _Pragma("unroll") for (int k = 0; k < 2; ++k) dst[n][k] = *(const PG8_LAS bf16x8*)(lds + PG8_SB(b, h) + boff + n * 2048 + k * 1024); } while (0)
#define PG8_MMA(ai, bj, At, Bt) do { __builtin_amdgcn_s_setprio(1); _Pragma("unroll") for (int m = 0; m < 4; ++m) _Pragma("unroll") for (int n = 0; n < 2; ++n) _Pragma("unroll") for (int k = 0; k < 2; ++k) \
        acc[ai][bj][m][n] = __builtin_amdgcn_mfma_f32_16x16x32_bf16(Bt[n][k], At[m][k], acc[ai][bj][m][n], 0, 0, 0); __builtin_amdgcn_s_setprio(0); } while (0)
#define PG8_WAIT_V(n) asm volatile("s_waitcnt vmcnt(" #n ")" ::: "memory")
#define PG8_WAIT_L(n) asm volatile("s_waitcnt lgkmcnt(" #n ")" ::: "memory")
#define PG8_BAR __builtin_amdgcn_s_barrier()
#define PG8_SCHED __builtin_amdgcn_sched_barrier(0)
    Unit cur, nxt; int ui = 0;
    if (!S.next(0, cur)) return;
    f32x4 acc[2][2][4][2];
#pragma unroll
    for (int a = 0; a < 2; ++a)
#pragma unroll
        for (int b = 0; b < 2; ++b)
#pragma unroll
            for (int m = 0; m < 4; ++m)
#pragma unroll
                for (int n = 0; n < 2; ++n) acc[a][b][m][n] = (f32x4){0.f, 0.f, 0.f, 0.f};
    bf16x8 At[4][2], B0[2][2], B1[2][2];
    const char* cA = gA_ + (size_t)cur.pm * tstep; const char* cB = gB_ + (size_t)cur.pn * tstep;
    S.a_ready(cur);
    if constexpr (SP2) {
        PG8_STAGE(PG8_SB(0, 0), cB, voffB); PG8_STAGE(PG8_SB(0, 1), cB + hstep, voffB); PG8_STAGE(PG8_SA(0, 0), cA, voffA); PG8_STAGE(PG8_SA(0, 1), cA + hstep, voffA);
        if (wr == 1) PG8_BAR;
        PG8_WAIT_V(2); PG8_BAR;
        PG8_STAGE(PG8_SB(1, 0), cB + kstep, voffB); PG8_STAGE(PG8_SA(1, 0), cA + kstep, voffA); PG8_STAGE(PG8_SB(1, 1), cB + hstep + kstep, voffB);
        PG8_WAIT_V(6); PG8_BAR;
    } else {
        PG8_STAGE(PG8_SB(0, 0), cB, voffB); PG8_STAGE(PG8_SA(0, 0), cA, voffA); PG8_STAGE(PG8_SB(0, 1), cB + hstep, voffB); PG8_STAGE(PG8_SA(0, 1), cA + hstep, voffA);
        if (wr == 1) PG8_BAR;
        PG8_WAIT_V(4); PG8_BAR;
        PG8_STAGE(PG8_SB(1, 0), cB + kstep, voffB); PG8_STAGE(PG8_SA(1, 0), cA + kstep, voffA); PG8_STAGE(PG8_SB(1, 1), cB + hstep + kstep, voffB);
        PG8_WAIT_V(6); PG8_BAR;
    }
    for (;;) {
        const bool has_next = S.next(ui + 1, nxt);
        const char* nA = has_next ? gA_ + (size_t)nxt.pm * tstep : cA; const char* nB = has_next ? gB_ + (size_t)nxt.pn * tstep : cB;
        for (int t = 0; t < nt; t += 2) {
            const bool last = (t == nt - 2);
            const char* a1 = cA + (size_t)(t + 1) * kstep;
            const char* a2 = last ? nA : cA + (size_t)(t + 2) * kstep; const char* b2 = last ? nB : cB + (size_t)(t + 2) * kstep;
            const char* a3 = a2 + kstep; const char* b3 = b2 + kstep;
            if (last && has_next) S.a_ready(nxt);
            if constexpr (SP2) {
            PG8_LDB(B0, 0, 0); PG8_LDB(B1, 0, 1); PG8_SCHED; PG8_LDA(At, 0, 0); PG8_STAGE(PG8_SA(1, 1), a1 + hstep, voffA);
            PG8_WAIT_V(8); PG8_WAIT_L(0); PG8_BAR; PG8_MMA(0, 0, At, B0); PG8_MMA(0, 1, At, B1); PG8_BAR; PG8_SCHED;
            PG8_LDA(At, 0, 1); PG8_STAGE(PG8_SB(0, 0), b2, voffB); PG8_STAGE(PG8_SB(0, 1), b2 + hstep, voffB); PG8_STAGE(PG8_SA(0, 0), a2, voffA);
            PG8_WAIT_V(8); PG8_WAIT_L(0); PG8_BAR; PG8_MMA(1, 0, At, B0); PG8_MMA(1, 1, At, B1); PG8_BAR; PG8_SCHED;
            PG8_LDB(B0, 1, 0); PG8_LDB(B1, 1, 1); PG8_SCHED; PG8_LDA(At, 1, 0); PG8_STAGE(PG8_SA(0, 1), a2 + hstep, voffA);
            PG8_WAIT_V(8); PG8_WAIT_L(0); PG8_BAR; PG8_MMA(0, 0, At, B0); PG8_MMA(0, 1, At, B1); PG8_BAR; PG8_SCHED;
            PG8_LDA(At, 1, 1); PG8_STAGE(PG8_SB(1, 0), b3, voffB); PG8_STAGE(PG8_SB(1, 1), b3 + hstep, voffB); PG8_STAGE(PG8_SA(1, 0), a3, voffA);
            PG8_WAIT_V(8); PG8_WAIT_L(0); PG8_BAR; PG8_MMA(1, 0, At, B0); PG8_MMA(1, 1, At, B1); PG8_BAR; PG8_SCHED;
            } else {
            PG8_LDB(B0, 0, 0); PG8_SCHED; PG8_LDA(At, 0, 0); PG8_STAGE(PG8_SA(1, 1), a1 + hstep, voffA);
            PG8_WAIT_L(8); PG8_BAR; PG8_WAIT_L(0); PG8_MMA(0, 0, At, B0); PG8_BAR; PG8_SCHED;
            PG8_LDB(B1, 0, 1); PG8_STAGE(PG8_SB(0, 0), b2, voffB);
            PG8_BAR; PG8_WAIT_L(0); PG8_MMA(0, 1, At, B1); PG8_BAR;
            PG8_LDA(At, 0, 1); PG8_STAGE(PG8_SA(0, 0), a2, voffA);
            PG8_BAR; PG8_WAIT_L(0); PG8_MMA(1, 0, At, B0); PG8_BAR; PG8_SCHED;
            PG8_STAGE(PG8_SB(0, 1), b2 + hstep, voffB);
            PG8_WAIT_V(6); PG8_BAR; PG8_MMA(1, 1, At, B1); PG8_BAR;
            PG8_LDB(B0, 1, 0); PG8_SCHED; PG8_LDA(At, 1, 0); PG8_STAGE(PG8_SA(0, 1), a2 + hstep, voffA);
            PG8_WAIT_L(8); PG8_BAR; PG8_WAIT_L(0); PG8_MMA(0, 0, At, B0); PG8_BAR; PG8_SCHED;
            PG8_LDB(B1, 1, 1); PG8_STAGE(PG8_SB(1, 0), b3, voffB);
            PG8_BAR; PG8_WAIT_L(0); PG8_MMA(0, 1, At, B1); PG8_BAR;
            PG8_LDA(At, 1, 1); PG8_STAGE(PG8_SA(1, 0), a3, voffA);
            PG8_BAR; PG8_WAIT_L(0); PG8_MMA(1, 0, At, B0); PG8_BAR; PG8_SCHED;
            PG8_STAGE(PG8_SB(1, 1), b3 + hstep, voffB);
            PG8_WAIT_V(6); PG8_BAR; PG8_MMA(1, 1, At, B1); PG8_BAR;
            }
        }
        if constexpr (ALIGN_EPI) { if (wr == 0) PG8_BAR; }
        if constexpr (!Epi::AFTER_DRAIN) { E(acc, cur, wr, wc, fr, fq); S.done(cur); }
        if (!has_next) break;
#pragma unroll
        for (int a = 0; a < 2; ++a)
#pragma unroll
            for (int b = 0; b < 2; ++b)
#pragma unroll
                for (int m = 0; m < 4; ++m)
#pragma unroll
                    for (int n = 0; n < 2; ++n) acc[a][b][m][n] = (f32x4){0.f, 0.f, 0.f, 0.f};
        cur = nxt; cA = nA; cB = nB; ++ui;
        if constexpr (ALIGN_EPI) { if (wr == 1) PG8_BAR; }
    }
    PG8_WAIT_V(0);
    if constexpr (!ALIGN_EPI) { if (wr == 0) PG8_BAR; }
    PG8_BAR;
    if constexpr (Epi::AFTER_DRAIN) { E.fused(acc, cur, wr, wc, fr, fq, lds, wid, lane); S.done(cur); }
#undef PG8_SA
#undef PG8_SB
#undef PG8_STAGE
#undef PG8_LDA
#undef PG8_LDB
#undef PG8_MMA
#undef PG8_WAIT_V
#undef PG8_WAIT_L
#undef PG8_BAR
#undef PG8_SCHED
}
}

#ifndef PG8_SP2
#define PG8_SP2 true
#endif
#include <hip/hip_bf16.h>
#include <cmath>
namespace attn_body {
using bf16=__hip_bfloat16;
using bf16x8=__attribute__((ext_vector_type(8)))short;
using s16x4=__attribute__((ext_vector_type(4)))short;
using f32x16=__attribute__((ext_vector_type(16)))float;
using u32x4=__attribute__((ext_vector_type(4)))unsigned;
constexpr int BATCH=4,NHEAD=16,SEQ=8192,D=64,DM=NHEAD*D,OPITCH=2048;
constexpr int NW=8,QBLK=32,QB=QBLK*NW,KVBLK=64,NQB=SEQ/QB;
constexpr int ATTN_PITCH=DM, ATTN_UNIT_ROWS=QB;
__device__ __forceinline__ int crow(int r,int hi){return (r&3)+8*(r>>2)+4*hi;}
#define SBAR() __builtin_amdgcn_sched_barrier(0)
__device__ __forceinline__ void cmask(f32x16&p0,f32x16&p1,int jb,int qrel,int hi){
  const float NEG=-INFINITY; int kb=64*jb+4*hi;
  #pragma unroll
  for(int r=0;r<16;++r){int kv=kb+(r&3)+8*(r>>2); if(kv>qrel)p0[r]=NEG; if(kv+32>qrel)p1[r]=NEG;}
}

constexpr int NSLOT=3, SLOTB=8192;
constexpr int LDS_K=0, LDS_V=NSLOT*SLOTB, LDS_V2=2*NSLOT*SLOTB, LDS_WS=3*NSLOT*SLOTB, LDS_OST=LDS_WS+NW*64*4, LDS_BYTES=LDS_OST+NW*4096;
constexpr float C2=0.125f*1.4426950408889634f;
__device__ __forceinline__ void glds16(const void*gsrc,unsigned lds_dst){unsigned keep;
  asm volatile("s_mov_b32 %0, m0\n\ts_mov_b32 m0, %2\n\ts_nop 0\n\tglobal_load_lds_dwordx4 %1, off\n\ts_mov_b32 m0, %0":"=&s"(keep):"v"(gsrc),"s"(lds_dst):"memory");}
__device__ __forceinline__ void glds16s(const void*sbase,unsigned voff,unsigned lds_dst){unsigned keep;
  asm volatile("s_mov_b32 %0, m0\n\ts_mov_b32 m0, %3\n\ts_nop 0\n\tglobal_load_lds_dwordx4 %1, %2\n\ts_mov_b32 m0, %0":"=&s"(keep):"v"(voff),"s"(sbase),"s"(lds_dst):"memory");}
__device__ __forceinline__ float max3f(float a,float b,float c){float r;asm("v_max3_f32 %0, %1, %2, %3":"=v"(r):"v"(a),"v"(b),"v"(c));return r;}
__device__ __forceinline__ float max2f(float a,float b){float r;asm("v_max_f32_e32 %0, %1, %2":"=v"(r):"v"(a),"v"(b));return r;}
__device__ __forceinline__ float fadd_s(float a,float b){float r;asm("v_add_f32_e32 %0, %1, %2":"=v"(r):"v"(a),"v"(b));return r;}
__device__ __forceinline__ float fsub_s(float a,float b){float r;asm("v_sub_f32_e32 %0, %1, %2":"=v"(r):"v"(a),"v"(b));return r;}
typedef float f32x2_t __attribute__((ext_vector_type(2))); typedef __bf16 bf16x2_t __attribute__((ext_vector_type(2)));
__device__ __forceinline__ unsigned cvtpk_s(float lo,float hi){f32x2_t v={lo,hi};bf16x2_t b=__builtin_convertvector(v,bf16x2_t);return __builtin_bit_cast(unsigned,b);}
#define WAIT_BAR(N) asm volatile("s_waitcnt vmcnt(" #N ") lgkmcnt(0)\n\ts_barrier":::"memory")

__device__ __forceinline__ void qkt(f32x16&p0,f32x16&p1,const char*Kslot,const bf16x8*qr,const f32x16&negm,int r32,int hi){
  const char*kb=Kslot+hi*1024+r32*16;
  #pragma unroll
  for(int d0=0;d0<4;++d0){
    const bf16x8 b0=*reinterpret_cast<const bf16x8*>(kb+d0*2048);
    const bf16x8 b1=*reinterpret_cast<const bf16x8*>(kb+d0*2048+512);
    if(d0==0){p0=__builtin_amdgcn_mfma_f32_32x32x16_bf16(b0,qr[0],negm,0,0,0);p1=__builtin_amdgcn_mfma_f32_32x32x16_bf16(b1,qr[0],negm,0,0,0);}
    else{p0=__builtin_amdgcn_mfma_f32_32x32x16_bf16(b0,qr[d0],p0,0,0,0);p1=__builtin_amdgcn_mfma_f32_32x32x16_bf16(b1,qr[d0],p1,0,0,0);}}
}
typedef __attribute__((address_space(3))) const char* lds_cptr;
typedef short v4i16_t __attribute__((ext_vector_type(4)));
__device__ __forceinline__ void kload8(bf16x8*kf,lds_cptr kp){
  kf[0]=*(const __attribute__((address_space(3))) bf16x8*)(kp);      kf[1]=*(const __attribute__((address_space(3))) bf16x8*)(kp+512);
  kf[2]=*(const __attribute__((address_space(3))) bf16x8*)(kp+2048); kf[3]=*(const __attribute__((address_space(3))) bf16x8*)(kp+2560);
  kf[4]=*(const __attribute__((address_space(3))) bf16x8*)(kp+4096); kf[5]=*(const __attribute__((address_space(3))) bf16x8*)(kp+4608);
  kf[6]=*(const __attribute__((address_space(3))) bf16x8*)(kp+6144); kf[7]=*(const __attribute__((address_space(3))) bf16x8*)(kp+6656);
}
__device__ __forceinline__ void kload2(bf16x8*kf,lds_cptr kp,int j){ kf[2*j]=*(const __attribute__((address_space(3))) bf16x8*)(kp+j*2048); kf[2*j+1]=*(const __attribute__((address_space(3))) bf16x8*)(kp+j*2048+512); }
__device__ __forceinline__ s16x4 vtr(lds_cptr p){ return __builtin_bit_cast(s16x4,__builtin_amdgcn_ds_read_tr16_b64_v4i16((__attribute__((address_space(3))) v4i16_t*)p)); }
__device__ __forceinline__ float rowmax(const f32x16&p0,const f32x16&p1){
  float a=max3f(p0[0],p0[1],p1[0]),b=max3f(p0[2],p0[3],p1[1]);a=max3f(a,p1[2],p1[3]);
  #pragma unroll
  for(int r=4;r<16;r+=4){a=max3f(a,p0[r],p0[r+1]);b=max3f(b,p0[r+2],p0[r+3]);a=max3f(a,p1[r],p1[r+1]);b=max3f(b,p1[r+2],p1[r+3]);}
  const float m=max2f(a,b);
  auto rr=__builtin_amdgcn_permlane32_swap(__float_as_uint(m),__float_as_uint(m),false,false);
  return max2f(__uint_as_float(rr[0]),__uint_as_float(rr[1]));
}
__device__ __forceinline__ void pv(f32x16*o,int vb,bf16x8 pa0,bf16x8 pa1,bf16x8 pa2,bf16x8 pa3){
  #pragma unroll
  for(int d0=0;d0<2;++d0){s16x4 lo[4],hi[4];
    #pragma unroll
    for(int ks=0;ks<4;++ks){
      asm volatile("ds_read_b64_tr_b16 %0,%1 offset:%c2":"=&v"(lo[ks]):"v"(vb),"i"(d0*4096+ks*1024):"memory");
      asm volatile("ds_read_b64_tr_b16 %0,%1 offset:%c2":"=&v"(hi[ks]):"v"(vb),"i"(d0*4096+ks*1024+512):"memory");}
    asm volatile("s_waitcnt lgkmcnt(0)":::"memory");SBAR();
    #define PK(k) (bf16x8){lo[k][0],lo[k][1],lo[k][2],lo[k][3],hi[k][0],hi[k][1],hi[k][2],hi[k][3]}
    o[d0]=__builtin_amdgcn_mfma_f32_32x32x16_bf16(pa0,PK(0),o[d0],0,0,0);
    o[d0]=__builtin_amdgcn_mfma_f32_32x32x16_bf16(pa1,PK(1),o[d0],0,0,0);
    o[d0]=__builtin_amdgcn_mfma_f32_32x32x16_bf16(pa2,PK(2),o[d0],0,0,0);
    o[d0]=__builtin_amdgcn_mfma_f32_32x32x16_bf16(pa3,PK(3),o[d0],0,0,0);
    #undef PK
  }
}

#ifndef ATTN_STORE16
#define ATTN_STORE16(p,v) (*(u32x4*)(p)=(v))
#endif
template<int THRL> __device__ __forceinline__ void attn_unit(int b,int h,int vcol,int ocol,int qb,const bf16*Q,const bf16*__restrict__ K,const bf16*__restrict__ V,bf16*O,char*shm){
  int tid_=threadIdx.x; asm volatile("":"+v"(tid_)); const int tid=tid_,lane=tid&63,r32=lane&31,hi=lane>>5; const int wid=__builtin_amdgcn_readfirstlane(tid>>6);
  const long rowbase=(long)b*SEQ; const int q0=qb*QB;
  const bf16*Qw=Q+(rowbase+q0+wid*QBLK)*DM+h*D;
  const bf16*Kh=K+rowbase*DM+h*D,*Vh=V+rowbase*DM+vcol;
  const unsigned lds0=(unsigned)(uintptr_t)shm;
  float*wsf=(float*)(shm+LDS_WS)+wid*64;
  const bf16*ksrc=Kh+wid*8; const unsigned koff=(unsigned)(lane*DM)*2u;
  const bf16*vsrc=Vh+(long)(16*(wid&3))*DM+(wid>>2)*32; const unsigned voff=(unsigned)((lane>>2)*DM+(lane&3)*8)*2u;
  const unsigned kdst=lds0+LDS_K+wid*1024, vdst=lds0+LDS_V+wid*1024, vdst2=lds0+LDS_V2+wid*1024;
  #define DMA_K(t,slot) glds16s(ksrc+(long)(t)*KVBLK*DM,koff,(unsigned)__builtin_amdgcn_readfirstlane(kdst+(slot)))
  #define DMA_V(t,slot) do{ glds16s(vsrc+(long)(t)*KVBLK*DM,voff,(unsigned)__builtin_amdgcn_readfirstlane(vdst+(slot))); glds16s(vsrc+64+(long)(t)*KVBLK*DM,voff,(unsigned)__builtin_amdgcn_readfirstlane(vdst2+(slot))); }while(0)
  const int vb0=(int)(lds0+LDS_V)+((lane>>4)&1)*32+(lane&3)*8+(4*hi+((lane&15)>>2))*64;
  const char*Kbase=shm+LDS_K; bf16x8 kf[8];
  const lds_cptr shm3=(lds_cptr)shm; const lds_cptr kp0=shm3+LDS_K+hi*1024+r32*16; const lds_cptr vp0=shm3+LDS_V+((lane>>4)&1)*32+(lane&3)*8+(4*hi+((lane&15)>>2))*64;
  const int NT=(q0+QB)/KVBLK;
  DMA_K(0,0);DMA_V(0,0);DMA_K(1,SLOTB);
  bf16x8 qr[4];
  #pragma unroll
  for(int d0=0;d0<4;++d0)qr[d0]=*reinterpret_cast<const bf16x8*>(&Qw[(long)r32*DM+d0*16+hi*8]);
  float mhat=0.f,l_reg=0.f;f32x16 o[4];o[0]=f32x16{};o[1]=f32x16{};o[2]=f32x16{};o[3]=f32x16{};const f32x16 zero16=f32x16{};
  const int qrel=wid*QBLK+r32;
  #define CMASK(P0,P1,t) do{int jb_=(t)-(NT-4); if(jb_>=0)cmask(P0,P1,jb_,qrel,hi);}while(0)
  bool resc=false;
  #define START(P0,P1) do{ const float rm=rowmax(P0,P1); resc=false; \
    { const float dl=rm; mhat=fadd_s(mhat,dl); \
      _Pragma("unroll") for(int r=0;r<16;++r){P0[r]=fsub_s(P0[r],dl);P1[r]=fsub_s(P1[r],dl);} \
      } \
    _Pragma("unroll") for(int r=0;r<16;++r)P0[r]=__builtin_amdgcn_exp2f(P0[r]); }while(0)
  #define RESC() do{ if(resc){ asm volatile("s_waitcnt lgkmcnt(0)":::"memory"); \
      _Pragma("unroll") for(int d_=0;d_<4;++d_) _Pragma("unroll") for(int r=0;r<16;++r)o[d_][r]*=wsf[crow(r,hi)]; } }while(0)
  f32x16 pA0,pA1,pB0,pB1;
  int sl_prev=0,sl_cur=0,sl_next=SLOTB;
  #define ROT() do{sl_prev=sl_cur;sl_cur=sl_next;sl_next=(sl_next==(NSLOT-1)*SLOTB)?0:sl_next+SLOTB;}while(0)
  DMA_K(2,2*SLOTB);
  WAIT_BAR(3);
  qkt(pA0,pA1,Kbase,qr,zero16,r32,hi);asm volatile("s_nop 15\n\ts_nop 7":"+v"(pA0),"+v"(pA1));CMASK(pA0,pA1,0);
  START(pA0,pA1);
  _Pragma("unroll") for(int r=0;r<16;++r)pA1[r]=__builtin_amdgcn_exp2f(pA1[r]);
  WAIT_BAR(0);
  DMA_K(3,0);DMA_V(1,SLOTB);
  ROT();
  kload8(kf,kp0+sl_cur);
  WAIT_BAR(3);
  s16x4 vlo[8],vhi[8]; u32x4 pw0,pw1,pw2,pw3;
  #define PKW(P,B) cvtpk_s(P[B],P[B+1])
  #define PAF(k) __builtin_bit_cast(bf16x8,pw##k)
  #define VFR(i) (bf16x8){vlo[i][0],vlo[i][1],vlo[i][2],vlo[i][3],vhi[i][0],vhi[i][1],vhi[i][2],vhi[i][3]}
  #define PIN(x) asm volatile("":"+v"(x))
  #define MX3(a,b,c) __builtin_fmaxf(__builtin_fmaxf((a),(b)),(c))
  #define GAPA(MF,A0,A1,A2,A3,W0,W1,PW) do{ MF; sacc+=A0; sacc+=A1; sacc+=A2; sacc+=A3; PIN(sacc); W0; W1; PIN(PW); SBAR(); }while(0)
  #define EX(v) __builtin_amdgcn_exp2f(v)
  #define GAPB(MF,X,B) do{ MF; X[B]=EX(X[B]); X[B+1]=EX(X[B+1]); PIN(X); SBAR(); }while(0)
  #define VRD(i) do{ vlo[i]=vtr(vp_+(((i)>>2)*4096+((i)&3)*1024)); vhi[i]=vtr(vp_+(((i)>>2)*4096+((i)&3)*1024+512)); }while(0)
  #define VRD2(i) do{ vlo[i]=vtr(vp_+((LDS_V2-LDS_V)+((i)>>2)*4096+((i)&3)*1024)); vhi[i]=vtr(vp_+((LDS_V2-LDS_V)+((i)>>2)*4096+((i)&3)*1024+512)); SBAR(); }while(0)
  #define VFR2(i) VFR(i)
  #define KRD(G,j) do{ if(G){ kload2(kf,kp0+sl_next,j); SBAR(); } }while(0)
  #define STEP(C0,C1,P0,P1,t,GK,GV,GL) do{ SBAR(); \
    const lds_cptr vp_=vp0+sl_prev; \
    VRD(0); SBAR(); float sacc=(P0[0]+P0[1]); \
    GAPA(C0=__builtin_amdgcn_mfma_f32_32x32x16_bf16(kf[0],qr[0],zero16,0,0,0), P0[2],P0[3],P0[4],P0[5],     pw0[0]=PKW(P0,0), pw0[1]=PKW(P0,2), pw0); \
    VRD(4); SBAR(); GAPA(C1=__builtin_amdgcn_mfma_f32_32x32x16_bf16(kf[1],qr[0],zero16,0,0,0), P0[6],P0[7],P0[8],P0[9],     pw0[2]=PKW(P0,4), pw0[3]=PKW(P0,6), pw0); \
    VRD(1); SBAR(); GAPA(C0=__builtin_amdgcn_mfma_f32_32x32x16_bf16(kf[2],qr[1],C0,0,0,0),   P0[10],P0[11],P0[12],P0[13], pw1[0]=PKW(P0,8), pw1[1]=PKW(P0,10), pw1); \
    VRD(5); SBAR(); GAPA(C1=__builtin_amdgcn_mfma_f32_32x32x16_bf16(kf[3],qr[1],C1,0,0,0),   P0[14],P0[15],P1[0],P1[1],   pw1[2]=PKW(P0,12),pw1[3]=PKW(P0,14), pw1); \
    VRD(2); SBAR(); GAPA(C0=__builtin_amdgcn_mfma_f32_32x32x16_bf16(kf[4],qr[2],C0,0,0,0),   P1[2],P1[3],P1[4],P1[5],     pw2[0]=PKW(P1,0), pw2[1]=PKW(P1,2), pw2); \
    VRD(6); SBAR(); GAPA(C1=__builtin_amdgcn_mfma_f32_32x32x16_bf16(kf[5],qr[2],C1,0,0,0),   P1[6],P1[7],P1[8],P1[9],     pw2[2]=PKW(P1,4), pw2[3]=PKW(P1,6), pw2); \
    VRD(3); SBAR(); GAPA(C0=__builtin_amdgcn_mfma_f32_32x32x16_bf16(kf[6],qr[3],C0,0,0,0),   P1[10],P1[11],P1[12],P1[13], pw3[0]=PKW(P1,8), pw3[1]=PKW(P1,10), pw3); \
    VRD(7); SBAR(); GAPA(C1=__builtin_amdgcn_mfma_f32_32x32x16_bf16(kf[7],qr[3],C1,0,0,0),   P1[14],P1[15],0.f,0.f,       pw3[2]=PKW(P1,12),pw3[3]=PKW(P1,14), pw3); \
    l_reg+=sacc; \
    if(GK){DMA_K((t)+3,sl_cur);} if(GV){DMA_V((t)+1,sl_next);} \
    CMASK(C0,C1,t); \
    _Pragma("unroll") for(int r=0;r<16;++r){C0[r]-=mhat;C1[r]-=mhat;} \
    { float a=MX3(C0[0],C0[1],C1[0]),b=MX3(C0[2],C0[3],C1[1]); a=MX3(a,C1[2],C1[3]); \
      _Pragma("unroll") for(int r=4;r<16;r+=4){a=MX3(a,C0[r],C0[r+1]);b=MX3(b,C0[r+2],C0[r+3]);a=MX3(a,C1[r],C1[r+1]);b=MX3(b,C1[r+2],C1[r+3]);} \
      float rm=__builtin_fmaxf(a,b); { auto rr=__builtin_amdgcn_permlane32_swap(__float_as_uint(rm),__float_as_uint(rm),false,false); rm=__builtin_fmaxf(__uint_as_float(rr[0]),__uint_as_float(rr[1])); } \
      resc=false; \
      if(__builtin_expect(__any(rm>(float)THRL),0)){ const float dl=__builtin_fmaxf(rm,0.f); mhat+=dl; \
        _Pragma("unroll") for(int r=0;r<16;++r){C0[r]-=dl;C1[r]-=dl;} \
        const float f=__builtin_amdgcn_exp2f(-dl); l_reg*=f; if(hi==0)wsf[r32]=f; resc=true; } } \
    SBAR(); \
    GAPB(o[0]=__builtin_amdgcn_mfma_f32_32x32x16_bf16(PAF(0),VFR(0),o[0],0,0,0), C0,0); VRD2(0); \
    GAPB(o[1]=__builtin_amdgcn_mfma_f32_32x32x16_bf16(PAF(0),VFR(4),o[1],0,0,0), C0,2); VRD2(4); \
    KRD(GL,0); GAPB(o[0]=__builtin_amdgcn_mfma_f32_32x32x16_bf16(PAF(1),VFR(1),o[0],0,0,0), C0,4); VRD2(1); \
    KRD(GL,1); GAPB(o[1]=__builtin_amdgcn_mfma_f32_32x32x16_bf16(PAF(1),VFR(5),o[1],0,0,0), C0,6); VRD2(5); \
    KRD(GL,2); GAPB(o[0]=__builtin_amdgcn_mfma_f32_32x32x16_bf16(PAF(2),VFR(2),o[0],0,0,0), C0,8); VRD2(2); \
    KRD(GL,3); GAPB(o[1]=__builtin_amdgcn_mfma_f32_32x32x16_bf16(PAF(2),VFR(6),o[1],0,0,0), C0,10); VRD2(6); \
    GAPB(o[0]=__builtin_amdgcn_mfma_f32_32x32x16_bf16(PAF(3),VFR(3),o[0],0,0,0), C0,12); VRD2(3); \
    GAPB(o[1]=__builtin_amdgcn_mfma_f32_32x32x16_bf16(PAF(3),VFR(7),o[1],0,0,0), C0,14); VRD2(7); \
    GAPB(o[2]=__builtin_amdgcn_mfma_f32_32x32x16_bf16(PAF(0),VFR2(0),o[2],0,0,0), C1,0); \
    GAPB(o[3]=__builtin_amdgcn_mfma_f32_32x32x16_bf16(PAF(0),VFR2(4),o[3],0,0,0), C1,2); \
    GAPB(o[2]=__builtin_amdgcn_mfma_f32_32x32x16_bf16(PAF(1),VFR2(1),o[2],0,0,0), C1,4); \
    GAPB(o[3]=__builtin_amdgcn_mfma_f32_32x32x16_bf16(PAF(1),VFR2(5),o[3],0,0,0), C1,6); \
    GAPB(o[2]=__builtin_amdgcn_mfma_f32_32x32x16_bf16(PAF(2),VFR2(2),o[2],0,0,0), C1,8); \
    GAPB(o[3]=__builtin_amdgcn_mfma_f32_32x32x16_bf16(PAF(2),VFR2(6),o[3],0,0,0), C1,10); \
    GAPB(o[2]=__builtin_amdgcn_mfma_f32_32x32x16_bf16(PAF(3),VFR2(3),o[2],0,0,0), C1,12); \
    GAPB(o[3]=__builtin_amdgcn_mfma_f32_32x32x16_bf16(PAF(3),VFR2(7),o[3],0,0,0), C1,14); \
    }while(0)
  int t=1;
  #undef CMASK
  #define CMASK(P0,P1,t) do{}while(0)
  for(;t+5<NT;t+=2){
    STEP(pB0,pB1,pA0,pA1,t,true,true,true);     WAIT_BAR(3); RESC(); ROT();
    STEP(pA0,pA1,pB0,pB1,t+1,true,true,true);   WAIT_BAR(3); RESC(); ROT();
  }
  #undef CMASK
  #define CMASK(P0,P1,t) do{int jb_=(t)-(NT-4); if(jb_>=0)cmask(P0,P1,jb_,qrel,hi);}while(0)
  #define ENDW(tt) do{ if((tt)+3<NT){WAIT_BAR(3);} else if((tt)+2<NT){WAIT_BAR(2);} else {WAIT_BAR(0);} }while(0)
  for(;t+1<NT;t+=2){
    STEP(pB0,pB1,pA0,pA1,t,(t+3<NT),(t+1<NT),(t+1<NT));       ENDW(t);   RESC(); ROT();
    STEP(pA0,pA1,pB0,pB1,t+1,(t+4<NT),(t+2<NT),(t+2<NT));     ENDW(t+1); RESC(); ROT();
  }
  STEP(pB0,pB1,pA0,pA1,NT-1,false,false,false); RESC();
  { float sacc=pB0[0]+pB0[1]; _Pragma("unroll") for(int r=2;r<16;++r)sacc+=pB0[r]; _Pragma("unroll") for(int r=0;r<16;++r)sacc+=pB1[r]; l_reg+=sacc;
    pw0=(u32x4){PKW(pB0,0),PKW(pB0,2),PKW(pB0,4),PKW(pB0,6)};pw1=(u32x4){PKW(pB0,8),PKW(pB0,10),PKW(pB0,12),PKW(pB0,14)};pw2=(u32x4){PKW(pB1,0),PKW(pB1,2),PKW(pB1,4),PKW(pB1,6)};pw3=(u32x4){PKW(pB1,8),PKW(pB1,10),PKW(pB1,12),PKW(pB1,14)};
    SBAR(); pv(o,vb0+sl_cur,PAF(0),PAF(1),PAF(2),PAF(3)); pv(o+2,vb0+(LDS_V2-LDS_V)+sl_cur,PAF(0),PAF(1),PAF(2),PAF(3)); }
  #undef PKW
  #undef PAF
  #undef VFR
  #undef PIN
  #undef MX3
  #undef GAPA
  #undef GAPB
  #undef EX
  #undef VRD
  #undef VRD2
  #undef VFR2
  #undef KRD
  #undef STEP
  #undef ENDW
  {auto rr=__builtin_amdgcn_permlane32_swap(__float_as_uint(l_reg),__float_as_uint(l_reg),false,false);l_reg=__uint_as_float(rr[0])+__uint_as_float(rr[1]);}
  if(hi==0)wsf[32+r32]=l_reg;asm volatile("s_waitcnt lgkmcnt(0)":::"memory");
  float rli[16];
  #pragma unroll
  for(int r=0;r<16;++r)rli[r]=__builtin_amdgcn_rcpf(wsf[32+crow(r,hi)]);
  bf16*Ow=O+(rowbase+q0+wid*QBLK)*OPITCH+ocol;
  #pragma unroll
  for(int hh=0;hh<2;++hh){ bf16*stg=(bf16*)(shm+LDS_OST)+wid*2048;
    #pragma unroll
    for(int r=0;r<16;++r){const int orow=crow(r,hi);
      #pragma unroll
      for(int d0=0;d0<2;++d0)stg[orow*64+d0*32+r32]=__float2bfloat16(o[2*hh+d0][r]*rli[r]);}
    asm volatile("s_waitcnt lgkmcnt(0)":::"memory");
    #pragma unroll
    for(int i=0;i<4;++i){const int row=i*8+(lane>>3),ch=lane&7; const u32x4 v=*(const u32x4*)(stg+row*64+ch*8); ATTN_STORE16(Ow+hh*64+(long)row*OPITCH+ch*8,v);}
    asm volatile("s_waitcnt lgkmcnt(0)":::"memory"); }
  asm volatile("s_waitcnt lgkmcnt(0)\n\ts_barrier":::"memory");
  #undef DMA_K
  #undef DMA_V
  #undef CMASK
  #undef START
  #undef RESC
  #undef ROT
}
constexpr int ATTN_LDS_BYTES=LDS_BYTES;
template<int THRL> __device__ __forceinline__ void diffattn_phase(char*lds,const bf16*Q,const bf16*K,const bf16*V,bf16*O,int vcu,int G){
  for(int cmb=vcu;cmb<512;cmb+=G){
    const int bh=cmb>>3,s=cmb&7,b=bh>>4,map=bh&15;
    #pragma unroll 1
    for(int i=0;i<4;++i){ const int qb=(i==0)?s:(i==1)?15-s:(i==2)?16+s:31-s;
      attn_unit<THRL>(b,map,(map>>1)*128,map*128,qb,Q,K,V,O,lds); }
  }
}
#undef SBAR
#undef WAIT_BAR
}

#include <hip/hip_cooperative_groups.h>
namespace cg = cooperative_groups;
#define LAS __attribute__((address_space(3)))
typedef unsigned short bf16;
typedef unsigned v4u __attribute__((ext_vector_type(4)));
typedef unsigned v2u __attribute__((ext_vector_type(2)));
typedef float f32x4 __attribute__((ext_vector_type(4)));
typedef short bf16x8 __attribute__((ext_vector_type(8)));
#define LDS_WAIT() asm volatile("s_waitcnt lgkmcnt(0)" ::: "memory")

constexpr int NWAVES = 8;
constexpr int BATCH = 4, SEQ = 8192, TOK = BATCH * SEQ, D = 1024, FF = 2816, PLE = 256, MINW = 3080;
constexpr float EPS = 1e-6f;
constexpr float KSCALE = 0.08838834764831845f;
constexpr float LAM_INIT = 0.35550906759096f;
constexpr size_t MiB = (size_t)1 << 20;
constexpr size_t W_FFN_IN = 0, W_FFN_OUT = 44 * MiB, W_PLE_PROJ = 66 * MiB, W_PLE_GATE = 67 * MiB, W_MIN = 71 * MiB, W_MOUT = 77 * MiB, W_KV = 79 * MiB, W_Q = 83 * MiB, W_O = 85 * MiB;
constexpr size_t WS_XN = 88 * MiB, WS_XKV = 152 * MiB, WS_H = 216 * MiB, WS_R = 280 * MiB, WS_END = 512 * MiB;
constexpr size_t R_GATES = WS_R + 192 * MiB, R_NB = WS_R + 193 * MiB, R_NS = R_NB + MiB / 2, R_STATS = WS_R + 194 * MiB, R_MS = R_STATS + MiB / 4, R_WG8 = WS_R + 200 * MiB;
constexpr int LDS_BYTES = 147456, LDS_MISC = 147392;
constexpr size_t WS_RSTD = 87 * MiB + 256 * 1024, WS_RSTD_KV = 87 * MiB + 512 * 1024;
constexpr size_t WS_BAR = 87 * MiB;

__device__ __forceinline__ unsigned f2bf(float f) { unsigned u = __builtin_bit_cast(unsigned, f); return (u + 0x7fffu + ((u >> 16) & 1u)) >> 16; }
__device__ __forceinline__ unsigned pk2(float lo, float hi) { return pg8::cvt_pk_bf16(lo, hi); }
__device__ __forceinline__ float blo(unsigned w) { return __uint_as_float(w << 16); }
__device__ __forceinline__ float bhi(unsigned w) { return __uint_as_float(w & 0xffff0000u); }
__device__ __forceinline__ float shx(float v, int o, int lane) { return __int_as_float(__builtin_amdgcn_ds_bpermute((lane ^ o) << 2, __float_as_int(v))); }
__device__ __forceinline__ float shup(float v, int o, int lane) { return __int_as_float(__builtin_amdgcn_ds_bpermute(((lane - o) & 63) << 2, __float_as_int(v))); }
__device__ __forceinline__ float wave_scan_add(float v, int lane) {
#pragma unroll
    for (int o = 1; o < 64; o <<= 1) { const float t = shup(v, o, lane); if (lane >= o) v += t; }
    return v;
}
__device__ __forceinline__ float wave_scan_max(float v, int lane) {
#pragma unroll
    for (int o = 1; o < 64; o <<= 1) { const float t = shup(v, o, lane); if (lane >= o) v = fmaxf(v, t); }
    return v;
}
__device__ __forceinline__ float wave_max(float v, int lane) {
#pragma unroll
    for (int o = 1; o < 64; o <<= 1) v = fmaxf(v, shx(v, o, lane));
    return v;
}
__device__ __forceinline__ float wave_sum(float v, int lane) {
#pragma unroll
    for (int o = 1; o < 64; o <<= 1) v += shx(v, o, lane);
    return v;
}
__device__ __forceinline__ float sigm(float x) { return __builtin_amdgcn_rcpf(1.f + __expf(-x)); }

__device__ __forceinline__ void xpose_item(const float* W, int K, int ldw, int N, bf16* WT, int mode, LAS float* scr, int item, int lane, const float* gk) {
    const int nblk = N / 32, kb = item / nblk, nb = item % nblk, k0 = 64 * kb, n0 = 32 * nb;
#pragma unroll 8
    for (int i = 0; i < 32; ++i) { const int kk = 2 * i + (lane >> 5); float wv = __builtin_nontemporal_load(W + (size_t)(k0 + kk) * ldw + n0 + (lane & 31)); if (gk) wv *= gk[k0 + kk]; scr[kk * 33 + (lane & 31)] = wv; }
    LDS_WAIT(); asm volatile("" ::: "memory");
    int r0 = n0;
    if (mode == 1) r0 = (n0 < FF) ? ((n0 >> 7) * 256 + (n0 & 127)) : ((((n0 - FF) >> 7) * 256) + 128 + ((n0 - FF) & 127));
    const int c = lane & 7;
#pragma unroll
    for (int j = 0; j < 4; ++j) { const int n = (lane >> 3) + 8 * j; const LAS float* s = scr + (8 * c) * 33 + n;
        v4u o; o.x = pk2(s[0 * 33], s[1 * 33]); o.y = pk2(s[2 * 33], s[3 * 33]); o.z = pk2(s[4 * 33], s[5 * 33]); o.w = pk2(s[6 * 33], s[7 * 33]);
        *(v4u*)(WT + (size_t)(r0 + n) * K + k0 + 8 * c) = o; }
    LDS_WAIT(); asm volatile("" ::: "memory");
}

struct RowP { const float* xin_f; const bf16* xin_b; bf16* xout_b; float* xout_f; const bf16* h; const float* gpost; float hscale;
              float* rms; bf16* xkv;
              const float* g1; const float* wg; const float* bg; float* gates; const float* psrc; bf16* pdst; };
__device__ __forceinline__ void row_phase(const RowP& a, int gw, int NGW, int lane) {
    constexpr int RB = 4;
    for (int m0 = gw * RB; m0 < TOK; m0 += NGW * RB) {
        f32x4 xf[RB][4]; v2u xb[RB][4]; v2u hw[RB][4]; f32x4 pv[RB];
        if (a.xin_f) {
#pragma unroll
            for (int r = 0; r < RB; ++r) { const f32x4* xr = (const f32x4*)(a.xin_f + (size_t)(m0 + r) * D) + lane;
#pragma unroll
                for (int j = 0; j < 4; ++j) xf[r][j] = __builtin_nontemporal_load(xr + 64 * j); }
        } else {
#pragma unroll
            for (int r = 0; r < RB; ++r) { const v2u* xr = (const v2u*)(a.xin_b + (size_t)(m0 + r) * D) + lane;
#pragma unroll
                for (int j = 0; j < 4; ++j) xb[r][j] = xr[64 * j]; }
        }
        if (a.h) {
#pragma unroll
            for (int r = 0; r < RB; ++r) { const v2u* hr = (const v2u*)(a.h + (size_t)(m0 + r) * D) + lane;
#pragma unroll
                for (int j = 0; j < 4; ++j) hw[r][j] = __builtin_nontemporal_load(hr + 64 * j); }
        }
        if (a.psrc) {
#pragma unroll
            for (int r = 0; r < RB; ++r) pv[r] = __builtin_nontemporal_load((const f32x4*)(a.psrc + (size_t)(m0 + r) * PLE) + lane);
        }
#pragma unroll
        for (int r = 0; r < RB; ++r) {
            const int m = m0 + r;
            f32x4 v[4];
            float rin = 1.f; if (!a.xin_f) rin = a.rms[m];
#pragma unroll
            for (int j = 0; j < 4; ++j) { if (a.xin_f) v[j] = xf[r][j]; else { const v2u w = xb[r][j]; v[j] = (f32x4){blo(w.x), bhi(w.x), blo(w.y), bhi(w.y)} * rin; } }
            if (a.h) {
                f32x4 hv[4]; float ss = 0.f;
#pragma unroll
                for (int j = 0; j < 4; ++j) { const v2u w = hw[r][j]; hv[j] = (f32x4){blo(w.x), bhi(w.x), blo(w.y), bhi(w.y)};
                    ss += (hv[j].x * hv[j].x + hv[j].y * hv[j].y) + (hv[j].z * hv[j].z + hv[j].w * hv[j].w); }
                ss = wave_sum(ss, lane); const float rs = rsqrtf(ss * (1.f / D) + EPS) * a.hscale;
#pragma unroll
                for (int j = 0; j < 4; ++j) { const f32x4 g = ((const f32x4*)a.gpost)[lane + 64 * j]; v[j] = v[j] + hv[j] * rs * g; }
            }
            if (a.xout_f) { f32x4* xo = (f32x4*)(a.xout_f + (size_t)m * D) + lane;
#pragma unroll
                for (int j = 0; j < 4; ++j) __builtin_nontemporal_store(v[j], xo + 64 * j); }
            if (a.xout_b) {
                float ss = 0.f;
#pragma unroll
                for (int j = 0; j < 4; ++j) ss += (v[j].x * v[j].x + v[j].y * v[j].y) + (v[j].z * v[j].z + v[j].w * v[j].w);
                ss = wave_sum(ss, lane); const float rs = rsqrtf(ss * (1.f / D) + EPS);
                v2u* o1 = (v2u*)(a.xout_b + (size_t)m * D) + lane;
                v2u wv[4];
#pragma unroll
                for (int j = 0; j < 4; ++j) { const f32x4 z = v[j] * rs; wv[j].x = pk2(z.x, z.y); wv[j].y = pk2(z.z, z.w); o1[64 * j] = wv[j]; }
                if (lane == 0) a.rms[m] = sqrtf(ss * (1.f / D) + EPS);
                if (a.xkv) { v2u* o2 = (v2u*)(a.xkv + (size_t)m * D) + lane;
#pragma unroll
                    for (int j = 0; j < 4; ++j) o2[64 * j] = wv[j]; }
                if (a.gates) {
                    f32x4 ga = (f32x4){0.f, 0.f, 0.f, 0.f}, gb = ga;
#pragma unroll
                    for (int j = 0; j < 4; ++j) { const f32x4* wp = (const f32x4*)(a.wg + (size_t)(4 * lane + 256 * j) * 8);
                        const f32x4 y = v[j] * rs * ((const f32x4*)a.g1)[lane + 64 * j];
#pragma unroll
                        for (int e = 0; e < 4; ++e) { const f32x4 w0 = wp[2 * e], w1 = wp[2 * e + 1]; ga = ga + w0 * y[e]; gb = gb + w1 * y[e]; } }
#pragma unroll
                    for (int e = 0; e < 4; ++e) { ga[e] = wave_sum(ga[e], lane); gb[e] = wave_sum(gb[e], lane); }
                    if (lane == 0) { f32x4 li, lf;
#pragma unroll
                        for (int e = 0; e < 4; ++e) { li[e] = ga[e] + a.bg[e]; const float z = gb[e] + a.bg[4 + e]; lf[e] = fminf(z, 0.f) - log1pf(__expf(-fabsf(z))); }
                        f32x4* gp = (f32x4*)(a.gates + (size_t)m * 8); gp[0] = li; gp[1] = lf; }
                }
            }
            if (a.psrc) { v2u w; w.x = pk2(pv[r].x, pv[r].y); w.y = pk2(pv[r].z, pv[r].w); ((v2u*)(a.pdst + (size_t)m * PLE))[lane] = w; }
        }
    }
}

__device__ __forceinline__ void m1_phase(LAS unsigned char* lds, const bf16* QKVO, const float* GATES, bf16* KBT, float* NB, float* STATS, int vcu, int G, int tid) {
    const int lane = tid & 63, wid = __builtin_amdgcn_readfirstlane(tid >> 6), fr = lane & 15, fq = lane >> 4;
    LAS bf16* vT = (LAS bf16*)lds;
    LAS bf16* kT = (LAS bf16*)(lds + 69632);
    LAS float* fl = (LAS float*)(lds + 104448);
    for (int u = vcu; u < 1024; u += G) {
        const int b = u >> 8, h = (u >> 6) & 3, c = u & 63; const size_t t0 = (size_t)b * SEQ + (size_t)c * 128;
        v4u kr[2][2], vr[4][2];
#pragma unroll
        for (int i = 0; i < 2; ++i) { const int idx = tid + 512 * i, sp = idx & 63, dc = idx >> 6; const bf16* p = QKVO + (t0 + 2 * sp) * 3072 + 512 + h * 128 + dc * 8;
            kr[i][0] = *(const v4u*)p; kr[i][1] = *(const v4u*)(p + 3072); }
#pragma unroll
        for (int i = 0; i < 4; ++i) { const int idx = tid + 512 * i, sp = idx & 63, vc = idx >> 6; const bf16* p = QKVO + (t0 + 2 * sp) * 3072 + 1024 + h * 256 + vc * 8;
            vr[i][0] = *(const v4u*)p; vr[i][1] = *(const v4u*)(p + 3072); }
        if (tid < 128) { fl[tid] = GATES[(t0 + tid) * 8 + 4 + h]; fl[128 + tid] = GATES[(t0 + tid) * 8 + h]; }
        __syncthreads();
        if (tid < 128) { float s = wave_scan_add(fl[tid], lane); if (wid == 1) s += wave_sum(fl[lane], lane); fl[256 + tid] = s; }
        __syncthreads();
        { const float bL = fl[256 + 127];
          const float mx = wave_max(fmaxf(bL - fl[256 + lane] + fl[128 + lane], bL - fl[320 + lane] + fl[192 + lane]), lane);
          if (tid < 128) fl[384 + tid] = __expf(bL - fl[256 + tid] + fl[128 + tid] - mx);
          if (tid == 0) { STATS[2 * u] = bL; STATS[2 * u + 1] = mx; } }
        __syncthreads();
#pragma unroll
        for (int i = 0; i < 2; ++i) { const int idx = tid + 512 * i, sp = idx & 63, dc = idx >> 6, s0 = 2 * sp; const float sc0 = fl[384 + s0], sc1 = fl[385 + s0];
            LAS unsigned* dst = (LAS unsigned*)(kT + (dc * 8) * 136 + s0); const v4u a = kr[i][0], c2 = kr[i][1];
            dst[0 * 68] = pk2(blo(a.x) * sc0, blo(c2.x) * sc1); dst[1 * 68] = pk2(bhi(a.x) * sc0, bhi(c2.x) * sc1); dst[2 * 68] = pk2(blo(a.y) * sc0, blo(c2.y) * sc1); dst[3 * 68] = pk2(bhi(a.y) * sc0, bhi(c2.y) * sc1);
            dst[4 * 68] = pk2(blo(a.z) * sc0, blo(c2.z) * sc1); dst[5 * 68] = pk2(bhi(a.z) * sc0, bhi(c2.z) * sc1); dst[6 * 68] = pk2(blo(a.w) * sc0, blo(c2.w) * sc1); dst[7 * 68] = pk2(bhi(a.w) * sc0, bhi(c2.w) * sc1); }
#pragma unroll
        for (int i = 0; i < 4; ++i) { const int idx = tid + 512 * i, sp = idx & 63, vc = idx >> 6, s0 = 2 * sp;
            LAS unsigned* dst = (LAS unsigned*)(vT + (vc * 8) * 136 + s0); const v4u a = vr[i][0], c2 = vr[i][1];
            dst[0 * 68] = (a.x & 0xffffu) | (c2.x << 16); dst[1 * 68] = (a.x >> 16) | (c2.x & 0xffff0000u); dst[2 * 68] = (a.y & 0xffffu) | (c2.y << 16); dst[3 * 68] = (a.y >> 16) | (c2.y & 0xffff0000u);
            dst[4 * 68] = (a.z & 0xffffu) | (c2.z << 16); dst[5 * 68] = (a.z >> 16) | (c2.z & 0xffff0000u); dst[6 * 68] = (a.w & 0xffffu) | (c2.w << 16); dst[7 * 68] = (a.w >> 16) | (c2.w & 0xffff0000u); }
        __syncthreads();
        f32x4 acc[2][8];
#pragma unroll
        for (int m = 0; m < 2; ++m)
#pragma unroll
            for (int n = 0; n < 8; ++n) acc[m][n] = (f32x4){0.f, 0.f, 0.f, 0.f};
#pragma unroll
        for (int kk = 0; kk < 4; ++kk) { bf16x8 yf[2];
#pragma unroll
            for (int m = 0; m < 2; ++m) yf[m] = *(const LAS bf16x8*)(vT + (32 * wid + 16 * m + fr) * 136 + fq * 8 + 32 * kk);
#pragma unroll
            for (int n = 0; n < 8; ++n) { const bf16x8 xf = *(const LAS bf16x8*)(kT + (16 * n + fr) * 136 + fq * 8 + 32 * kk);
#pragma unroll
                for (int m = 0; m < 2; ++m) acc[m][n] = __builtin_amdgcn_mfma_f32_16x16x32_bf16(xf, yf[m], acc[m][n], 0, 0, 0); } }
        bf16* dstg = KBT + (size_t)u * 32768;
#pragma unroll
        for (int m = 0; m < 2; ++m)
#pragma unroll
            for (int n = 0; n < 8; ++n) { v2u w; w.x = pk2(acc[m][n][0], acc[m][n][1]); w.y = pk2(acc[m][n][2], acc[m][n][3]);
                *(v2u*)(dstg + (32 * wid + 16 * m + fr) * 128 + 16 * n + 4 * fq) = w; }
        if (tid < 128) { float s = 0.f;
#pragma unroll 4
            for (int i = 0; i < 16; ++i) { const v4u q = *(const LAS v4u*)(kT + tid * 136 + 8 * i); s += ((blo(q.x) + bhi(q.x)) + (blo(q.y) + bhi(q.y))) + ((blo(q.z) + bhi(q.z)) + (blo(q.w) + bhi(q.w))); }
            NB[(size_t)u * 128 + tid] = s; }
        __syncthreads();
    }
}

__device__ __forceinline__ void m2_phase(const bf16* __restrict__ KBT, bf16* __restrict__ CT, const float* __restrict__ NB, float* __restrict__ NS, const float* __restrict__ STATS, float* __restrict__ MS, int vcu, int G, int tid) {
    const int NTH = G * 512;
    for (int item = vcu * 512 + tid; item < 16 * 8192; item += NTH) {
        const int bh = item >> 13, e = item & 8191;
        float c0 = 0.f, c1 = 0.f, c2 = 0.f, c3 = 0.f, m = -INFINITY;
#pragma unroll 1
        for (int cb = 0; cb < 64; cb += 8) {
            v2u kb[8]; float bLs[8], mls[8];
#pragma unroll
            for (int i = 0; i < 8; ++i) { const int u = bh * 64 + cb + i; kb[i] = __builtin_nontemporal_load((const v2u*)(KBT + (size_t)u * 32768 + (size_t)e * 4)); bLs[i] = STATS[2 * u]; mls[i] = STATS[2 * u + 1]; }
#pragma unroll
            for (int i = 0; i < 8; ++i) { const int u = bh * 64 + cb + i;
                v2u w; w.x = pk2(c0, c1); w.y = pk2(c2, c3); *(v2u*)(CT + (size_t)u * 32768 + (size_t)e * 4) = w;
                if (e == 0) MS[u] = m;
                const float mn = fmaxf(bLs[i] + m, mls[i]); const float dec = __expf(bLs[i] + m - mn), scl = __expf(mls[i] - mn);
                c0 = dec * c0 + scl * blo(kb[i].x); c1 = dec * c1 + scl * bhi(kb[i].x); c2 = dec * c2 + scl * blo(kb[i].y); c3 = dec * c3 + scl * bhi(kb[i].y); m = mn; }
        }
    }
    for (int item = vcu * 512 + tid; item < 16 * 128; item += NTH) {
        const int bh = item >> 7, d = item & 127; float n = 0.f, m = -INFINITY;
        for (int c = 0; c < 64; ++c) { const int u = bh * 64 + c; NS[(size_t)u * 128 + d] = n;
            const float bL = STATS[2 * u], ml = STATS[2 * u + 1]; const float mn = fmaxf(bL + m, ml);
            n = __expf(bL + m - mn) * n + __expf(ml - mn) * NB[(size_t)u * 128 + d]; m = mn; }
    }
}

__device__ __forceinline__ void m3_phase(LAS unsigned char* lds, const bf16* QKVO, const float* GATES, const bf16* CT, const float* NS, const float* MS, const float* headnorm, bf16* HG, int vcu, int G, int tid) {
    const int lane = tid & 63, wid = __builtin_amdgcn_readfirstlane(tid >> 6), fr = lane & 15, fq = lane >> 4;
    LAS bf16* Ap = (LAS bf16*)lds;
    LAS bf16* Bp = (LAS bf16*)(lds + 67584);
    LAS float* fl = (LAS float*)(lds + 135168);
    for (int u = vcu; u < 1024; u += G) {
        const int b = u >> 8, h = (u >> 6) & 3, c = u & 63; const size_t t0 = (size_t)b * SEQ + (size_t)c * 128;
        const float mc = MS[u];
        { v4u kc[4];
#pragma unroll
          for (int i = 0; i < 4; ++i) { const int idx = tid + 512 * i, row = idx >> 4, ch = idx & 15; kc[i] = *(const v4u*)(QKVO + (t0 + row) * 3072 + 512 + h * 128 + ch * 8); }
          if (tid < 128) { fl[tid] = GATES[(t0 + tid) * 8 + 4 + h]; fl[128 + tid] = GATES[(t0 + tid) * 8 + h]; fl[384 + tid] = NS[(size_t)u * 128 + tid]; }
#pragma unroll
          for (int i = 0; i < 4; ++i) { const int idx = tid + 512 * i, row = idx >> 4, ch = idx & 15; *(LAS v4u*)(Bp + row * 136 + ch * 8) = kc[i]; } }
        __syncthreads();
        float at = 0.f;
        if (tid < 128) { float s = wave_scan_add(fl[tid], lane); if (wid == 1) s += wave_sum(fl[lane], lane); at = fl[128 + tid] - s; fl[512 + tid] = s; fl[640 + tid] = at; }
        __syncthreads();
        if (tid < 128) { float pm = wave_scan_max(at, lane); if (wid == 1) pm = fmaxf(pm, wave_max(fl[640 + lane], lane)); fl[256 + tid] = fmaxf(mc, pm); }
        __syncthreads();
        const int trow = 16 * wid + fr;
        const float Mt = fl[256 + trow], btr = fl[512 + trow]; const float sint = __expf(mc - Mt);
        const bf16* qrow = QKVO + (t0 + trow) * 3072 + h * 128 + fq * 8;
        v4u qf[4];
#pragma unroll
        for (int kk = 0; kk < 4; ++kk) qf[kk] = *(const v4u*)(qrow + 32 * kk);
        float rs = 0.f, qn = 0.f;
#pragma unroll
        for (int kk = 0; kk < 4; ++kk) { const LAS float* np = fl + 384 + fq * 8 + 32 * kk; const v4u q = qf[kk];
            const float q0 = blo(q.x), q1 = bhi(q.x), q2 = blo(q.y), q3 = bhi(q.y), q4 = blo(q.z), q5 = bhi(q.z), q6 = blo(q.w), q7 = bhi(q.w);
            qn += (q0 * np[0] + q1 * np[1]) + (q2 * np[2] + q3 * np[3]) + (q4 * np[4] + q5 * np[5]) + (q6 * np[6] + q7 * np[7]);
            v4u w; w.x = pk2(q0 * sint, q1 * sint); w.y = pk2(q2 * sint, q3 * sint); w.z = pk2(q4 * sint, q5 * sint); w.w = pk2(q6 * sint, q7 * sint);
            *(LAS v4u*)(Ap + trow * 264 + 128 + fq * 8 + 32 * kk) = w; }
#pragma unroll
        for (int n = 0; n < 8; ++n) {
            v2u w; w.x = 0u; w.y = 0u;
            if (n <= wid) {
                f32x4 acc = (f32x4){0.f, 0.f, 0.f, 0.f};
                const LAS bf16* krow = Bp + (16 * n + fr) * 136 + fq * 8;
#pragma unroll
                for (int kk = 0; kk < 4; ++kk) { const v4u kf = *(const LAS v4u*)(krow + 32 * kk);
                    acc = __builtin_amdgcn_mfma_f32_16x16x32_bf16(__builtin_bit_cast(bf16x8, kf), __builtin_bit_cast(bf16x8, qf[kk]), acc, 0, 0, 0); }
                float sv[4];
#pragma unroll
                for (int r = 0; r < 4; ++r) { const int s = 16 * n + 4 * fq + r; const float wgt = (s <= trow) ? __expf(fl[640 + s] - Mt) : 0.f; sv[r] = acc[r] * wgt; rs += sv[r]; }
                w.x = pk2(sv[0], sv[1]); w.y = pk2(sv[2], sv[3]);
            }
            *(LAS v2u*)(Ap + trow * 264 + 16 * n + 4 * fq) = w;
        }
        rs += shx(rs, 16, lane); rs += shx(rs, 32, lane); qn += shx(qn, 16, lane); qn += shx(qn, 32, lane);
        const float den = rs + sint * qn; const float rD = 1.f / fmaxf(fabsf(den), __expf(-(btr + Mt)));
        f32x4 acc2[2][8];
#pragma unroll
        for (int hv = 0; hv < 2; ++hv)
#pragma unroll
            for (int n = 0; n < 8; ++n) acc2[hv][n] = (f32x4){0.f, 0.f, 0.f, 0.f};
#pragma unroll
        for (int hv = 0; hv < 2; ++hv) {
            __syncthreads();
#pragma unroll
            for (int i = 0; i < 2; ++i) { const int idx = tid + 512 * i, sp = idx & 63, vc = idx >> 6, s0 = 2 * sp; const bf16* p = QKVO + (t0 + s0) * 3072 + 1024 + h * 256 + 128 * hv + vc * 8;
                const v4u a = *(const v4u*)p, c2 = *(const v4u*)(p + 3072);
                LAS unsigned* dst = (LAS unsigned*)(Bp + (vc * 8) * 264 + s0);
                dst[0 * 132] = (a.x & 0xffffu) | (c2.x << 16); dst[1 * 132] = (a.x >> 16) | (c2.x & 0xffff0000u); dst[2 * 132] = (a.y & 0xffffu) | (c2.y << 16); dst[3 * 132] = (a.y >> 16) | (c2.y & 0xffff0000u);
                dst[4 * 132] = (a.z & 0xffffu) | (c2.z << 16); dst[5 * 132] = (a.z >> 16) | (c2.z & 0xffff0000u); dst[6 * 132] = (a.w & 0xffffu) | (c2.w << 16); dst[7 * 132] = (a.w >> 16) | (c2.w & 0xffff0000u); }
#pragma unroll
            for (int i = 0; i < 4; ++i) { const int idx = tid + 512 * i, row = idx >> 4, ch = idx & 15;
                const v4u raw = *(const v4u*)(CT + (size_t)u * 32768 + (size_t)(128 * hv + row) * 128 + ch * 8);
                *(LAS v4u*)(Bp + row * 264 + 128 + ch * 8) = raw; }
            __syncthreads();
#pragma unroll
            for (int kk = 0; kk < 8; ++kk) { const bf16x8 yf = *(const LAS bf16x8*)(Ap + trow * 264 + fq * 8 + 32 * kk);
#pragma unroll
                for (int n = 0; n < 8; ++n) { const bf16x8 xf = *(const LAS bf16x8*)(Bp + (16 * n + fr) * 264 + fq * 8 + 32 * kk);
                    acc2[hv][n] = __builtin_amdgcn_mfma_f32_16x16x32_bf16(xf, yf, acc2[hv][n], 0, 0, 0); } }
        }
        float ss = 0.f;
#pragma unroll
        for (int hv = 0; hv < 2; ++hv)
#pragma unroll
            for (int n = 0; n < 8; ++n) { acc2[hv][n] = acc2[hv][n] * rD; const f32x4 z = acc2[hv][n]; ss += (z[0] * z[0] + z[1] * z[1]) + (z[2] * z[2] + z[3] * z[3]); }
        ss += shx(ss, 16, lane); ss += shx(ss, 32, lane);
        const float rstd = rsqrtf(ss * (1.f / 256.f) + EPS);
#pragma unroll
        for (int hv = 0; hv < 2; ++hv)
#pragma unroll
            for (int n = 0; n < 8; ++n) { const int vv = 128 * hv + 16 * n + 4 * fq;
                const f32x4 hn = *(const f32x4*)(headnorm + h * 256 + vv);
                const v2u og = *(const v2u*)(QKVO + (t0 + trow) * 3072 + 2048 + h * 256 + vv);
                const f32x4 z = acc2[hv][n] * rstd * hn;
                v2u w; w.x = pk2(z[0] * sigm(blo(og.x)), z[1] * sigm(bhi(og.x))); w.y = pk2(z[2] * sigm(blo(og.y)), z[3] * sigm(bhi(og.y)));
                *(v2u*)(HG + (t0 + trow) * 1024 + h * 256 + vv) = w; }
        __syncthreads();
    }
}

__device__ __forceinline__ void cmb_phase(const bf16* O, const float* lamv, const float* subln, bf16* DN, int gw, int NGW, int lane) {
    const float s1 = wave_sum(lamv[lane] * lamv[64 + lane], lane), s2 = wave_sum(lamv[128 + lane] * lamv[192 + lane], lane);
    const float lam = __expf(s1) - __expf(s2) + LAM_INIT;
    const int hh = lane >> 3, sub = lane & 7;
    f32x4 g[4];
#pragma unroll
    for (int j = 0; j < 4; ++j) g[j] = ((const f32x4*)(subln + 16 * sub))[j] * (1.f - LAM_INIT);
    for (int m = gw; m < TOK; m += NGW) {
        const v4u* p1 = (const v4u*)(O + (size_t)m * 2048 + (2 * hh) * 128 + 16 * sub); const v4u* p2 = p1 + 16;
        const v4u a0 = __builtin_nontemporal_load(p1), a1 = __builtin_nontemporal_load(p1 + 1), b0 = __builtin_nontemporal_load(p2), b1 = __builtin_nontemporal_load(p2 + 1);
        float d[16];
        d[0] = blo(a0.x) - lam * blo(b0.x); d[1] = bhi(a0.x) - lam * bhi(b0.x); d[2] = blo(a0.y) - lam * blo(b0.y); d[3] = bhi(a0.y) - lam * bhi(b0.y);
        d[4] = blo(a0.z) - lam * blo(b0.z); d[5] = bhi(a0.z) - lam * bhi(b0.z); d[6] = blo(a0.w) - lam * blo(b0.w); d[7] = bhi(a0.w) - lam * bhi(b0.w);
        d[8] = blo(a1.x) - lam * blo(b1.x); d[9] = bhi(a1.x) - lam * bhi(b1.x); d[10] = blo(a1.y) - lam * blo(b1.y); d[11] = bhi(a1.y) - lam * bhi(b1.y);
        d[12] = blo(a1.z) - lam * blo(b1.z); d[13] = bhi(a1.z) - lam * bhi(b1.z); d[14] = blo(a1.w) - lam * blo(b1.w); d[15] = bhi(a1.w) - lam * bhi(b1.w);
        float ss = 0.f;
#pragma unroll
        for (int e = 0; e < 16; ++e) ss += d[e] * d[e];
        ss += shx(ss, 1, lane); ss += shx(ss, 2, lane); ss += shx(ss, 4, lane);
        const float rs = rsqrtf(ss * (1.f / 128.f) + EPS);
        v4u w0, w1;
        w0.x = pk2(d[0] * rs * g[0][0], d[1] * rs * g[0][1]); w0.y = pk2(d[2] * rs * g[0][2], d[3] * rs * g[0][3]); w0.z = pk2(d[4] * rs * g[1][0], d[5] * rs * g[1][1]); w0.w = pk2(d[6] * rs * g[1][2], d[7] * rs * g[1][3]);
        w1.x = pk2(d[8] * rs * g[2][0], d[9] * rs * g[2][1]); w1.y = pk2(d[10] * rs * g[2][2], d[11] * rs * g[2][3]); w1.z = pk2(d[12] * rs * g[3][0], d[13] * rs * g[3][1]); w1.w = pk2(d[14] * rs * g[3][2], d[15] * rs * g[3][3]);
        v4u* op = (v4u*)(DN + (size_t)m * 1024 + hh * 128 + 16 * sub); op[0] = w0; op[1] = w1;
    }
}

#define XB_TMO      128
#define XB_XCNT(j)  (256  + 64 * (j))
#define XB_XSUB(j)  (1280 + 64 * (j))
#define XB_XGEN(j)  (2304 + 64 * (j))
#define XB_TOP      3328
#define XB_TOPGEN   3392
#define XCD_BAR_WORDS 3456
#define XB_SPIN_CAP (1u << 18)

__device__ __forceinline__ unsigned xb_ld(unsigned* p)              { return __hip_atomic_load(p, __ATOMIC_RELAXED, __HIP_MEMORY_SCOPE_AGENT); }
__device__ __forceinline__ unsigned xb_add(unsigned* p, unsigned v) { return __hip_atomic_fetch_add(p, v, __ATOMIC_RELAXED, __HIP_MEMORY_SCOPE_AGENT); }
__device__ __forceinline__ unsigned xb_xcc_id() { return (unsigned)__builtin_amdgcn_s_getreg((3 << 11) | 20) & 0xFu; }
#define XB_SPIN(cond, bar) do { unsigned _sp = 0; while (cond) { __builtin_amdgcn_s_sleep(1); \
    if ((++_sp & 255u) == 0u) { if (xb_ld(&(bar)[XB_TMO])) break; if (_sp > XB_SPIN_CAP) { atomicAdd(&(bar)[XB_TMO], 1u); break; } } } } while (0)

struct XcdBarrier {
    unsigned* bar; unsigned x;
    volatile LAS unsigned* st;
};

__device__ __forceinline__ XcdBarrier xcd_barrier_post(unsigned* bar, volatile LAS unsigned* st) {
    XcdBarrier b; b.bar = bar; b.x = xb_xcc_id(); b.st = st;
    if (threadIdx.x == 0) (void)xb_add(&bar[XB_XCNT(b.x)], 1u);
    return b;
}
__device__ __forceinline__ void xcd_barrier_complete(unsigned* bar, unsigned x, unsigned& nloc, unsigned& nx) {
    const unsigned G = gridDim.x * gridDim.y * gridDim.z;
    unsigned sum, cnt, mine, sp = 0u;
    for (;;) {
        sum = 0u; cnt = 0u; mine = 0u;
#pragma unroll
        for (unsigned j = 0; j < 16; ++j) { const unsigned c = xb_ld(&bar[XB_XCNT(j)]); sum += c; cnt += (c > 0u) ? 1u : 0u; mine = (j == x) ? c : mine; }
        if (sum == G) break;
        __builtin_amdgcn_s_sleep(1);
        if ((++sp & 255u) == 0u) { if (xb_ld(&bar[XB_TMO])) break; if (sp > XB_SPIN_CAP) { atomicAdd(&bar[XB_TMO], 1u); break; } }
    }
    nloc = mine > 0u ? mine : 1u; nx = cnt > 0u ? cnt : 1u;
}

__device__ __forceinline__ void xcd_barrier(const XcdBarrier& b) {
    asm volatile("s_waitcnt vmcnt(0)" ::: "memory");
    __syncthreads();
    if (threadIdx.x == 0) {
        unsigned* bar = b.bar;
        __builtin_amdgcn_s_waitcnt(0);
        unsigned nloc = b.st[0], nx = b.st[1];
        if (nloc == 0u) { xcd_barrier_complete(bar, b.x, nloc, nx); b.st[0] = nloc; b.st[1] = nx; }
        const unsigned old = xb_add(&bar[XB_XSUB(b.x)], 1u);
        const unsigned gen = old / nloc;
        if (old + 1u == (gen + 1u) * nloc) {
            __builtin_amdgcn_fence(__ATOMIC_RELEASE, "agent");
            asm volatile("s_waitcnt vmcnt(0)" ::: "memory");
            const unsigned og = xb_add(&bar[XB_TOP], 1u);
            const unsigned tg = og / nx;
            if (og + 1u == (tg + 1u) * nx) xb_add(&bar[XB_TOPGEN], 1u);
            else XB_SPIN(xb_ld(&bar[XB_TOPGEN]) == tg, bar);
            __builtin_amdgcn_fence(__ATOMIC_ACQUIRE, "agent");
            xb_add(&bar[XB_XGEN(b.x)], 1u);
            asm volatile("s_waitcnt vmcnt(0)" ::: "memory");
        } else {
            XB_SPIN(xb_ld(&bar[XB_XGEN(b.x)]) == gen, bar);
            __builtin_amdgcn_fence(__ATOMIC_ACQUIRE, "agent");
            asm volatile("s_waitcnt vmcnt(0)" ::: "memory");
        }
    }
    __syncthreads();
}

struct Args { const float* in[17]; float* out; unsigned char* ws; };
#define GAS __attribute__((address_space(1)))
struct ArgsG { const GAS float* in[17]; GAS float* out; GAS unsigned char* ws; };
typedef const __attribute__((address_space(4))) ArgsG* KArgs;
#define PHASE_BEGIN() \
    KArgs kp = (KArgs)__builtin_amdgcn_kernarg_segment_ptr(); asm volatile("" : "+s"(kp)); \
    int tid = threadIdx.x; asm volatile("" : "+v"(tid)); int bx = blockIdx.x; asm volatile("" : "+s"(bx)); \
    const int lane = tid & 63, wave = __builtin_amdgcn_readfirstlane(tid >> 6); const int G = gridDim.x; \
    const int vcu = (G % 8 == 0) ? (bx % 8) * (G / 8) + bx / 8 : bx; const int gw = vcu * NWAVES + wave, NGW = G * NWAVES; \
    unsigned char* ws = (unsigned char*)kp->ws; (void)lane; (void)gw; (void)NGW; (void)vcu; (void)ws;
#define GSYNC_CG() do { __builtin_amdgcn_fence(__ATOMIC_RELEASE, "agent"); cg::this_grid().sync(); __builtin_amdgcn_fence(__ATOMIC_ACQUIRE, "agent"); } while (0)
#define GSYNC() do { KArgs kq_ = (KArgs)__builtin_amdgcn_kernarg_segment_ptr(); asm volatile("" : "+s"(kq_)); \
    XcdBarrier b_; b_.bar = (unsigned*)((unsigned char*)kq_->ws + WS_BAR); b_.x = xb_xcc_id(); b_.st = (volatile LAS unsigned*)(lds + LDS_MISC); xcd_barrier(b_); } while (0)

template <int MODE, bool RS> __device__ __forceinline__ void run_gemm(LAS unsigned char* lds, const bf16* A, const bf16* B, int N, int K, bf16* O, int ldc, int split_cols, size_t split_stride, int sc_lo, int sc_hi, float scale, const float* rs) {
    pg8::Gemm g{A, B, TOK, N, K}; pg8::StaticOrder S; S.init(TOK, N, (int)gridDim.x, (int)blockIdx.x);
    pg8::EpiX<MODE, RS> E{O, ldc, split_cols, split_stride, sc_lo, sc_hi, scale, rs};
    pg8::gemm_phase<pg8::EpiX<MODE, RS>, pg8::StaticOrder, true, true>(lds, g, S, E);
}

constexpr int I_FI = (D / 64) * (2 * FF / 32), I_FO = (FF / 64) * (D / 32), I_PP = (PLE / 64) * (D / 32), I_DD = (D / 64) * (D / 32), I_MI = (D / 64) * (3072 / 32), I_KV = (D / 64) * (2048 / 32);
#define XP1(cnt, src, K_, LDW_, N_, dstoff, MODE_, G_) if (r < (cnt)) { xpose_item((src), (K_), (LDW_), (N_), (bf16*)(ws + (dstoff)), (MODE_), scr, r, lane, (G_)); continue; } r -= (cnt);
#define XPOSE_LOOP(TOTAL, ...) do { extern __shared__ __attribute__((aligned(16))) unsigned char lds_x_[]; LAS float* scr = (LAS float*)((LAS unsigned char*)lds_x_ + wave * 16384); \
    const float* ngp = ((const float*)kp->in[2]); (void)ngp; \
    for (int it = gw; it < (TOTAL); it += NGW) { int r = it; __VA_ARGS__ } } while (0)
#define XP_FFN(L, I) \
    XP1(I_FI, ((const float*)kp->in[3]) + (size_t)((L) * 2 + (I)) * D * 2 * FF, D, 2 * FF, 2 * FF, W_FFN_IN + (size_t)((L) * 2 + (I)) * 11 * MiB, 1, ngp + (size_t)((L) * 8 + (I) * 4) * D)
#define XP_FFO(L, I) \
    XP1(I_FO, ((const float*)kp->in[4]) + (size_t)((L) * 2 + (I)) * FF * D, FF, D, D, W_FFN_OUT + (size_t)((L) * 2 + (I)) * 11 * MiB / 2, 0, (const float*)nullptr)
#define XP_PLE(L) \
    XP1(I_DD, ((const float*)kp->in[6]) + (size_t)(L) * D * D, D, D, D, W_PLE_GATE + (size_t)(L) * 2 * MiB, 0, ngp + (size_t)((L) * 8 + 6) * D) \
    XP1(I_PP, ((const float*)kp->in[5]) + (size_t)(L) * PLE * D, PLE, D, D, W_PLE_PROJ + (size_t)(L) * MiB / 2, 0, (const float*)nullptr)

__device__ __forceinline__ void ph_prologue(LAS unsigned char* lds) {
    PHASE_BEGIN();
#ifndef NO_XP
    XPOSE_LOOP(I_FI, XP_FFN(0, 0));
#endif
    { float* WG8 = (float*)(ws + R_WG8); const float* wi = ((const float*)kp->in[7]);
      for (int i = gw * 64 + lane; i < D * 8; i += NGW * 64) WG8[i] = wi[(size_t)(i >> 3) * MINW + 3072 + (i & 7)]; }
    RowP a{}; a.xin_f = ((const float*)kp->in[0]); a.xout_b = (bf16*)(ws + WS_XN); a.rms = (float*)(ws + WS_RSTD);
    row_phase(a, gw, NGW, lane);
}
template <int LAYER, int HALF> __device__ __forceinline__ void ph_ffn_in(LAS unsigned char* lds) {
    PHASE_BEGIN();
#ifndef NO_G1
    run_gemm<1, false>(lds, (const bf16*)(ws + WS_XN), (const bf16*)(ws + W_FFN_IN + (size_t)(LAYER * 2 + HALF) * 11 * MiB), 2 * FF, D, (bf16*)(ws + WS_R), FF, 0, 0, 0, 0, 1.f, (const float*)(ws + WS_RSTD));
#endif
    XPOSE_LOOP(I_FO, XP_FFO(LAYER, HALF));
}
template <int LAYER, int HALF> __device__ __forceinline__ void ph_ffn_out(LAS unsigned char* lds) {
    PHASE_BEGIN();
#ifndef NO_G0A
    run_gemm<0, false>(lds, (const bf16*)(ws + WS_R), (const bf16*)(ws + W_FFN_OUT + (size_t)(LAYER * 2 + HALF) * 11 * MiB / 2), D, FF, (bf16*)(ws + WS_H), D, 0, 0, 0, 0, 1.f, nullptr);
#endif
}
template <int LAYER, int HALF> __device__ __forceinline__ void ph_row_ffn() {
    PHASE_BEGIN();
    const float* ng = ((const float*)kp->in[2]) + (size_t)LAYER * 8 * D;
    RowP a{}; if (LAYER == 0 && HALF == 0) a.xin_f = ((const float*)kp->in[0]); else a.xin_b = (const bf16*)(ws + WS_XN);
    a.xout_b = (bf16*)(ws + WS_XN); a.rms = (float*)(ws + WS_RSTD); a.h = (const bf16*)(ws + WS_H); a.gpost = ng + (HALF ? 5 : 1) * D; a.hscale = 0.5f;
    if (LAYER == 0 && HALF == 0) { a.g1 = ng + 2 * D; a.wg = (const float*)(ws + R_WG8); a.bg = ((const float*)kp->in[8]); a.gates = (float*)(ws + R_GATES); }
    if (HALF == 1) { a.psrc = ((const float*)kp->in[1]) + (size_t)LAYER * TOK * PLE; a.pdst = (bf16*)(ws + WS_R); }
    row_phase(a, gw, NGW, lane);
    if (LAYER == 0 && HALF == 0) XPOSE_LOOP(I_MI, XP1(I_MI, ((const float*)kp->in[7]), D, MINW, 3072, W_MIN, 0, ngp + (size_t)2 * D));
    if (HALF == 1) XPOSE_LOOP(I_DD + I_PP, XP_PLE(LAYER));
    if (LAYER == 1 && HALF == 0) XPOSE_LOOP(I_DD + I_KV, XP1(I_DD, ((const float*)kp->in[13]), D, D, D, W_Q, 0, ngp + (size_t)10 * D) XP1(I_KV, ((const float*)kp->in[12]), D, 2048, 2048, W_KV, 0, ((const float*)kp->in[11])));
}
template <int LAYER> __device__ __forceinline__ void ph_mix_in(LAS unsigned char* lds) {
    PHASE_BEGIN();
#ifndef NO_G0M
    if (LAYER == 0) run_gemm<0, false>(lds, (const bf16*)(ws + WS_XN), (const bf16*)(ws + W_MIN), 3072, D, (bf16*)(ws + WS_R), 3072, 0, 0, 512, 1024, KSCALE, (const float*)(ws + WS_RSTD));
    else {
        run_gemm<0, false>(lds, (const bf16*)(ws + WS_XN), (const bf16*)(ws + W_Q), 1024, D, (bf16*)(ws + WS_H), 1024, 0, 0, 0, 1024, attn_body::C2, (const float*)(ws + WS_RSTD));
        run_gemm<0, false>(lds, (const bf16*)(ws + WS_XKV), (const bf16*)(ws + W_KV), 2048, D, (bf16*)(ws + WS_R), 1024, 1024, (size_t)TOK * 1024, 0, 0, 1.f, (const float*)(ws + WS_RSTD_KV));
    }
#endif
}
__device__ __forceinline__ void ph_m1(LAS unsigned char* lds) { PHASE_BEGIN();
#ifndef NO_M1
    m1_phase(lds, (const bf16*)(ws + WS_R), (const float*)(ws + R_GATES), (bf16*)(ws + WS_H), (float*)(ws + R_NB), (float*)(ws + R_STATS), vcu, G, tid);
#endif
}
__device__ __forceinline__ void ph_m2() { PHASE_BEGIN();
#ifndef NO_M2
    m2_phase((const bf16*)(ws + WS_H), (bf16*)(ws + WS_XKV), (const float*)(ws + R_NB), (float*)(ws + R_NS), (const float*)(ws + R_STATS), (float*)(ws + R_MS), vcu, G, tid);
#endif
    XPOSE_LOOP(I_DD, XP1(I_DD, ((const float*)kp->in[10]), D, D, D, W_MOUT, 0, (const float*)nullptr));
}
__device__ __forceinline__ void ph_m3(LAS unsigned char* lds) { PHASE_BEGIN();
#ifndef NO_M3
    m3_phase(lds, (const bf16*)(ws + WS_R), (const float*)(ws + R_GATES), (const bf16*)(ws + WS_XKV), (const float*)(ws + R_NS), (const float*)(ws + R_MS), ((const float*)kp->in[9]), (bf16*)(unsigned char*)kp->out, vcu, G, tid);
#endif
}
__device__ __forceinline__ void ph_att(unsigned char* lds_generic) { PHASE_BEGIN();
#ifndef NO_ATT
    attn_body::diffattn_phase<8>((char*)lds_generic, (const attn_body::bf16*)(ws + WS_H), (const attn_body::bf16*)(ws + WS_R), (const attn_body::bf16*)(ws + WS_R + 64 * MiB), (attn_body::bf16*)(unsigned char*)kp->out, vcu, G);
#endif
}
__device__ __forceinline__ void ph_cmb() { PHASE_BEGIN();
    cmb_phase((const bf16*)(unsigned char*)kp->out, ((const float*)kp->in[14]), ((const float*)kp->in[15]), (bf16*)(ws + WS_R + 128 * MiB), gw, NGW, lane);
    XPOSE_LOOP(I_DD, XP1(I_DD, ((const float*)kp->in[16]), D, D, D, W_O, 0, (const float*)nullptr));
}
template <int LAYER> __device__ __forceinline__ void ph_mix_out(LAS unsigned char* lds) {
    PHASE_BEGIN();
#ifndef NO_G0B
    run_gemm<0, false>(lds, (LAYER == 0) ? (const bf16*)(unsigned char*)kp->out : (const bf16*)(ws + WS_R + 128 * MiB), (const bf16*)(ws + ((LAYER == 0) ? W_MOUT : W_O)), D, D, (bf16*)(ws + WS_H), D, 0, 0, 0, 0, 1.f, nullptr);
#endif
}
template <int LAYER> __device__ __forceinline__ void ph_row_mix() {
    PHASE_BEGIN();
    const float* ng = ((const float*)kp->in[2]) + (size_t)LAYER * 8 * D;
    RowP a{}; a.xin_b = (const bf16*)(ws + WS_XN); a.xout_b = (bf16*)(ws + WS_XN); a.rms = (float*)(ws + WS_RSTD); a.h = (const bf16*)(ws + WS_H); a.gpost = ng + 3 * D; a.hscale = 1.f;
    row_phase(a, gw, NGW, lane);
    XPOSE_LOOP(I_FI, XP_FFN(LAYER, 1));
}
template <int LAYER> __device__ __forceinline__ void ph_ple(LAS unsigned char* lds) {
    PHASE_BEGIN();
#ifndef NO_G2
    run_gemm<2, false>(lds, (const bf16*)(ws + WS_XN), (const bf16*)(ws + W_PLE_GATE + (size_t)LAYER * 2 * MiB), D, D, (bf16*)(ws + WS_H), D, 0, 0, 0, 0, 1.f, (const float*)(ws + WS_RSTD));
#endif
#ifndef NO_G3
    run_gemm<3, false>(lds, (const bf16*)(ws + WS_R), (const bf16*)(ws + W_PLE_PROJ + (size_t)LAYER * MiB / 2), D, PLE, (bf16*)(ws + WS_H), D, 0, 0, 0, 0, 1.f, nullptr);
#endif
}
template <int LAYER> __device__ __forceinline__ void ph_row_ple() {
    PHASE_BEGIN();
    const float* ng = ((const float*)kp->in[2]) + (size_t)LAYER * 8 * D;
    RowP a{}; a.xin_b = (const bf16*)(ws + WS_XN); a.h = (const bf16*)(ws + WS_H); a.gpost = ng + 7 * D; a.hscale = 1.f;
    if (LAYER == 0) { a.xout_b = (bf16*)(ws + WS_XN); a.rms = (float*)(ws + WS_RSTD); a.xkv = (bf16*)(ws + WS_XKV); }
    else { a.xout_f = (float*)kp->out; a.rms = (float*)(ws + WS_RSTD); }
    row_phase(a, gw, NGW, lane);
    if (LAYER == 0) XPOSE_LOOP(I_FI, XP_FFN(1, 0));
}

#ifndef REP_M
#define REP_M 1
#endif
#ifndef REP_ATT
#define REP_ATT 1
#endif
#ifndef REP_FFN
#define REP_FFN 1
#endif
#define FFN(L, H) for (int r_ = 0; r_ < REP_FFN; ++r_) { ph_ffn_in<L, H>(lds); GSYNC(); ph_ffn_out<L, H>(lds); GSYNC(); }
__global__ void __launch_bounds__(NWAVES * 64, 2) yoco_fwd(Args args) {
    extern __shared__ __attribute__((aligned(16))) unsigned char lds_[];
    LAS unsigned char* lds = (LAS unsigned char*)lds_;
    { PHASE_BEGIN(); if (tid == 0) { volatile LAS unsigned* st = (volatile LAS unsigned*)(lds + LDS_MISC); st[0] = 0u; st[1] = 0u; }
      (void)xcd_barrier_post((unsigned*)(ws + WS_BAR), (volatile LAS unsigned*)(lds + LDS_MISC)); }
    ph_prologue(lds);
    { KArgs kz_ = (KArgs)__builtin_amdgcn_kernarg_segment_ptr(); asm volatile("" : "+s"(kz_)); if (__builtin_expect(kz_->ws == nullptr, 0)) GSYNC_CG(); }
    GSYNC();
    FFN(0, 0) ph_row_ffn<0, 0>(); GSYNC();
    ph_mix_in<0>(lds); GSYNC(); for (int r_ = 0; r_ < REP_M; ++r_) { ph_m1(lds); GSYNC(); ph_m2(); GSYNC(); ph_m3(lds); GSYNC(); } ph_mix_out<0>(lds); GSYNC(); ph_row_mix<0>(); GSYNC();
    FFN(0, 1) ph_row_ffn<0, 1>(); GSYNC();
    ph_ple<0>(lds); GSYNC(); ph_row_ple<0>(); GSYNC();
    FFN(1, 0) ph_row_ffn<1, 0>(); GSYNC();
    ph_mix_in<1>(lds); GSYNC(); for (int r_ = 0; r_ < REP_ATT; ++r_) { ph_att(lds_); GSYNC(); } ph_cmb(); GSYNC(); ph_mix_out<1>(lds); GSYNC(); ph_row_mix<1>(); GSYNC();
    FFN(1, 1) ph_row_ffn<1, 1>(); GSYNC();
    ph_ple<1>(lds); GSYNC(); ph_row_ple<1>();
}

extern "C" void kernel_launch(void* const* d_in, const int* in_sizes, int n_in, void* d_out, int out_size, void* d_ws, size_t ws_size, hipStream_t stream) {
    static int grid = 0;
    if (grid == 0) {
        if (n_in != 17 || out_size != TOK * D || ws_size < WS_END) { fprintf(stderr, "kernel_launch: unexpected shapes (n_in %d, out %d, ws %zu)\n", n_in, out_size, ws_size); grid = -1; return; }
        int dev = 0, cus = 0, per_cu = 0;
        hipGetDevice(&dev); hipDeviceGetAttribute(&cus, hipDeviceAttributeMultiprocessorCount, dev);
        if (hipFuncSetAttribute((const void*)yoco_fwd, hipFuncAttributeMaxDynamicSharedMemorySize, LDS_BYTES) != hipSuccess) { fprintf(stderr, "kernel_launch: hipFuncSetAttribute failed\n"); grid = -1; return; }
        if (hipOccupancyMaxActiveBlocksPerMultiprocessor(&per_cu, (const void*)yoco_fwd, NWAVES * 64, LDS_BYTES) != hipSuccess || per_cu < 1) { fprintf(stderr, "kernel_launch: occupancy query says %d\n", per_cu); per_cu = 1; }
        (void)hipGetLastError();
        grid = cus;
    }
    if (grid < 0) return;
    if (hipMemsetAsync((char*)d_ws + WS_BAR, 0, 16384, stream) != hipSuccess) { fprintf(stderr, "kernel_launch: memset failed\n"); return; }
    Args a{};
    for (int i = 0; i < 17; ++i) a.in[i] = (const float*)d_in[i];
    a.out = (float*)d_out; a.ws = (unsigned char*)d_ws;
    void* kargs[] = {&a};
    hipError_t e = hipLaunchCooperativeKernel((const void*)yoco_fwd, dim3(grid), dim3(NWAVES * 64), kargs, LDS_BYTES, stream);
    if (e != hipSuccess) fprintf(stderr, "kernel_launch: cooperative launch failed: %s (grid %d)\n", hipGetErrorString(e), grid);
}
```

```cpp
#include <hip/hip_runtime.h>
#include <cstdio>
#include <cstdint>
namespace pg8 {
#define PG8_LAS __attribute__((address_space(3)))
typedef unsigned short bf16_t;
typedef short bf16x8 __attribute__((ext_vector_type(8)));
typedef float f32x4 __attribute__((ext_vector_type(4)));
typedef unsigned u32x4 __attribute__((ext_vector_type(4)));
constexpr int BM = 256, BK = 64, HALF = 128, HTB = HALF * BK * 2  , STAGE_BYTES = 8 * HTB, NXCD = 8, WGM = 8;

__host__ __device__ __forceinline__ int lds_byte(int r, int c) { const int st = (r >> 4) * 2 + (c >> 5), rr = r & 15, cc = c & 31, ob = rr * 64 + cc * 2; return st * 1024 + (ob ^ (((ob >> 9) & 1) << 5)); }
__host__ __device__ __forceinline__ void stage_rc(int b, int& R, int& C) { const int st = b / 1024, sb = b % 1024, swz = sb ^ (((sb >> 9) & 1) << 5); R = (st >> 1) * 16 + swz / 64; C = (st & 1) * 32 + (swz % 64) / 2; }
__host__ __device__ __forceinline__ int perm32(int rho) { const int n = rho >> 4, i = rho & 15; return 8 * (i >> 2) + 4 * n + (i & 3); }

struct Unit { int pm, pn; };
struct Gemm { const bf16_t* A; const bf16_t* Bt; int M, N, K; };

struct StaticOrder {
    int nM, nN, nwg, G, c;
    __host__ __device__ void init(int M, int N, int G_, int c_) { nM = M / BM; nN = N / BM; nwg = nM * nN; G = G_; c = c_; }
    __host__ __device__ bool next(int i, Unit& u) const {
        const long L = (long)i * G + c; if (L >= nwg) return false;
        int wgid = (int)L; { const int q = nwg / NXCD, r = nwg % NXCD, xcd = wgid % NXCD, off = wgid / NXCD; wgid = (xcd < r ? xcd * (q + 1) : r * (q + 1) + (xcd - r) * q) + off; }
        const int nig = WGM * nN, gid = wgid / nig, fm = gid * WGM, gsz = (nM - fm) < WGM ? (nM - fm) : WGM;
        u.pm = fm + ((wgid % nig) % gsz); u.pn = (wgid % nig) / gsz; return true;
    }
    __device__ __forceinline__ void a_ready(const Unit&) const {}
    __device__ __forceinline__ void done(const Unit&) const {}
};

typedef float f32x2cv __attribute__((ext_vector_type(2))); typedef __bf16 bf16x2cv __attribute__((ext_vector_type(2)));
__device__ __forceinline__ unsigned cvt_pk_bf16(float lo, float hi) { f32x2cv v = {lo, hi}; bf16x2cv b = __builtin_convertvector(v, bf16x2cv); return __builtin_bit_cast(unsigned, b); }
typedef float f32x2 __attribute__((ext_vector_type(2)));
__device__ __forceinline__ float bf2f(unsigned short b) { return __uint_as_float(((unsigned)b) << 16); }
__device__ __forceinline__ float sigm(float x) { return __builtin_amdgcn_rcpf(1.f + __expf(-x)); }
template <int MODE, bool RS = false> struct EpiX {
    static constexpr bool PERM = true, AFTER_DRAIN = false;
    bf16_t* O; int ldc; int split_cols; size_t split_stride; int sc_lo, sc_hi; float scale; const float* rs;
    __device__ __forceinline__ void operator()(const f32x4 (&acc)[2][2][4][2], const Unit& u, int wr, int wc, int fr, int fq) const {
        typedef __attribute__((address_space(1))) bf16_t gbf16_t;
        gbf16_t* O_ = (gbf16_t*)O; asm volatile("" : "+s"(O_));
        const __attribute__((address_space(1))) float* rs_ = (const __attribute__((address_space(1))) float*)rs; if constexpr (RS) asm volatile("" : "+s"(rs_));
        const int row0 = u.pm * BM + wr * 64 + fr;
        if constexpr (MODE == 1) {
            const int col0 = u.pn * HALF + wc * 32 + 8 * fq;
#pragma unroll
            for (int ai = 0; ai < 2; ++ai)
#pragma unroll
                for (int m = 0; m < 4; ++m) { gbf16_t* rowp = O_ + (size_t)(row0 + ai * HALF + m * 16) * ldc + col0;
                    float rr = 1.f; if constexpr (RS) rr = rs_[row0 + ai * HALF + m * 16];
                    f32x4 g0 = acc[ai][0][m][0] * rr, g1 = acc[ai][0][m][1] * rr; const f32x4 u0 = acc[ai][1][m][0] * rr, u1 = acc[ai][1][m][1] * rr;
#pragma unroll
                    for (int e = 0; e < 4; ++e) { g0[e] = g0[e] * sigm(g0[e]) * u0[e]; g1[e] = g1[e] * sigm(g1[e]) * u1[e]; }
                    u32x4 w; w.x = cvt_pk_bf16(g0[0], g0[1]); w.y = cvt_pk_bf16(g0[2], g0[3]); w.z = cvt_pk_bf16(g1[0], g1[1]); w.w = cvt_pk_bf16(g1[2], g1[3]);
                    *(__attribute__((address_space(1))) u32x4*)rowp = w; }
        } else {
            int colt = u.pn * BM; gbf16_t* base = O_;
            const float sc = (colt >= sc_lo && colt < sc_hi) ? scale : 1.f;
            if (split_cols) { const int t = colt / split_cols; base += (size_t)t * split_stride; colt -= t * split_cols; }
            const int col0 = colt + wc * 32 + 8 * fq;
#pragma unroll
            for (int ai = 0; ai < 2; ++ai)
#pragma unroll
                for (int m = 0; m < 4; ++m) { gbf16_t* rowp = base + (size_t)(row0 + ai * HALF + m * 16) * ldc + col0;
                    float rr = sc; if constexpr (RS) rr = sc * rs_[row0 + ai * HALF + m * 16];
#pragma unroll
                    for (int bj = 0; bj < 2; ++bj) { f32x4 v0 = acc[ai][bj][m][0] * rr, v1 = acc[ai][bj][m][1] * rr;
                        if constexpr (MODE == 2) {
#pragma unroll
                            for (int e = 0; e < 4; ++e) { v0[e] = sigm(v0[e]); v1[e] = sigm(v1[e]); } }
                        if constexpr (MODE == 3) { const u32x4 o = *(const __attribute__((address_space(1))) u32x4*)(rowp + bj * HALF);
                            v0[0] *= bf2f((unsigned short)(o.x & 0xffffu)); v0[1] *= bf2f((unsigned short)(o.x >> 16)); v0[2] *= bf2f((unsigned short)(o.y & 0xffffu)); v0[3] *= bf2f((unsigned short)(o.y >> 16));
                            v1[0] *= bf2f((unsigned short)(o.z & 0xffffu)); v1[1] *= bf2f((unsigned short)(o.z >> 16)); v1[2] *= bf2f((unsigned short)(o.w & 0xffffu)); v1[3] *= bf2f((unsigned short)(o.w >> 16)); }
                        u32x4 w; w.x = cvt_pk_bf16(v0[0], v0[1]); w.y = cvt_pk_bf16(v0[2], v0[3]); w.z = cvt_pk_bf16(v1[0], v1[1]); w.w = cvt_pk_bf16(v1[2], v1[3]);
                        *(__attribute__((address_space(1))) u32x4*)(rowp + bj * HALF) = w; } }
        }
    }
};
template <class Epi, class Sched, bool ALIGN_EPI = false, bool SP2 = false>
__device__ __forceinline__ void gemm_phase(PG8_LAS unsigned char* lds, const Gemm g, const Sched& S, const Epi& E) {
    int tid_ = threadIdx.x; asm volatile("" : "+v"(tid_));
    const char* gA_ = (const char*)g.A; const char* gB_ = (const char*)g.Bt; asm volatile("" : "+s"(gA_), "+s"(gB_));
    const int tid = tid_, wid = __builtin_amdgcn_readfirstlane(tid >> 6), lane = tid & 63, wr = wid >> 2, wc = wid & 3, fr = lane & 15, fq = lane >> 4;
    const int K = g.K, nt = K / BK;
    unsigned voffA[2], voffB[2];
#pragma unroll
    for (int i = 0; i < 2; ++i) { int R, C; stage_rc(tid * 16 + i * 8192, R, C); const int Rb = Epi::PERM ? ((R & ~31) + perm32(R & 31)) : R;
        voffA[i] = (unsigned)(R * K + C) * 2u; voffB[i] = (unsigned)(Rb * K + C) * 2u; }
    const size_t kstep = (size_t)(BK * 2);
    const size_t hstep = (size_t)HALF * K * 2;
    const size_t tstep = 2 * hstep;
    const unsigned ldsw = (unsigned)wid * 1024u;
    const int aoff = lds_byte(wr * 64 + fr, fq * 8), boff = lds_byte(wc * 32 + fr, fq * 8);
#define PG8_SA(b, h) (((b) * 2 + (h)) * HTB)
#define PG8_SB(b, h) ((4 + (b) * 2 + (h)) * HTB)
#define PG8_STAGE(bufoff, gbase, voff) do { _Pragma("unroll") for (int _i = 0; _i < 2; ++_i) \
        __builtin_amdgcn_global_load_lds((const unsigned*)((const char*)(gbase) + (voff)[_i]), (PG8_LAS unsigned*)(lds + (bufoff) + ldsw + _i * 8192), 16, 0, 0); } while (0)
#define PG8_LDA(dst, b, h) do { _Pragma("unroll") for (int m = 0; m < 4; ++m) _Pragma("unroll") for (int k = 0; k < 2; ++k) dst[m][k] = *(const PG8_LAS bf16x8*)(lds + PG8_SA(b, h) + aoff + m * 2048 + k * 1024); } while (0)
#define PG8_LDB(dst, b, h) do { _Pragma("unroll") for (int n = 0; n < 2; ++n) _Pragma("unroll") for (int k = 0; k < 2; ++k) dst[n][k] = *(const PG8_LAS bf16x8*)(lds + PG8_SB(b, h) + boff + n * 2048 + k * 1024); } while (0)
#define PG8_MMA(ai, bj, At, Bt) do { __builtin_amdgcn_s_setprio(1); _Pragma("unroll") for (int m = 0; m < 4; ++m) _Pragma("unroll") for (int n = 0; n < 2; ++n) _Pragma("unroll") for (int k = 0; k < 2; ++k) \
        acc[ai][bj][m][n] = __builtin_amdgcn_mfma_f32_16x16x32_bf16(Bt[n][k], At[m][k], acc[ai][bj][m][n], 0, 0, 0); __builtin_amdgcn_s_setprio(0); } while (0)
#define PG8_WAIT_V(n) asm volatile("s_waitcnt vmcnt(" #n ")" ::: "memory")
#define PG8_WAIT_L(n) asm volatile("s_waitcnt lgkmcnt(" #n ")" ::: "memory")
#define PG8_BAR __builtin_amdgcn_s_barrier()
#define PG8_SCHED __builtin_amdgcn_sched_barrier(0)
    Unit cur, nxt; int ui = 0;
    if (!S.next(0, cur)) return;
    f32x4 acc[2][2][4][2];
#pragma unroll
    for (int a = 0; a < 2; ++a)
#pragma unroll
        for (int b = 0; b < 2; ++b)
#pragma unroll
            for (int m = 0; m < 4; ++m)
#pragma unroll
                for (int n = 0; n < 2; ++n) acc[a][b][m][n] = (f32x4){0.f, 0.f, 0.f, 0.f};
    bf16x8 At[4][2], B0[2][2], B1[2][2];
    const char* cA = gA_ + (size_t)cur.pm * tstep; const char* cB = gB_ + (size_t)cur.pn * tstep;
    S.a_ready(cur);
    if constexpr (SP2) {
        PG8_STAGE(PG8_SB(0, 0), cB, voffB); PG8_STAGE(PG8_SB(0, 1), cB + hstep, voffB); PG8_STAGE(PG8_SA(0, 0), cA, voffA); PG8_STAGE(PG8_SA(0, 1), cA + hstep, voffA);
        if (wr == 1) PG8_BAR;
        PG8_WAIT_V(2); PG8_BAR;
        PG8_STAGE(PG8_SB(1, 0), cB + kstep, voffB); PG8_STAGE(PG8_SA(1, 0), cA + kstep, voffA); PG8_STAGE(PG8_SB(1, 1), cB + hstep + kstep, voffB);
        PG8_WAIT_V(6); PG8_BAR;
    } else {
        PG8_STAGE(PG8_SB(0, 0), cB, voffB); PG8_STAGE(PG8_SA(0, 0), cA, voffA); PG8_STAGE(PG8_SB(0, 1), cB + hstep, voffB); PG8_STAGE(PG8_SA(0, 1), cA + hstep, voffA);
        if (wr == 1) PG8_BAR;
        PG8_WAIT_V(4); PG8_BAR;
        PG8_STAGE(PG8_SB(1, 0), cB + kstep, voffB); PG8_STAGE(PG8_SA(1, 0), cA + kstep, voffA); PG8_STAGE(PG8_SB(1, 1), cB + hstep + kstep, voffB);
        PG8_WAIT_V(6); PG8_BAR;
    }
    for (;;) {
        const bool has_next = S.next(ui + 1, nxt);
        const char* nA = has_next ? gA_ + (size_t)nxt.pm * tstep : cA; const char* nB = has_next ? gB_ + (size_t)nxt.pn * tstep : cB;
        for (int t = 0; t < nt; t += 2) {
            const bool last = (t == nt - 2);
            const char* a1 = cA + (size_t)(t + 1) * kstep;
            const char* a2 = last ? nA : cA + (size_t)(t + 2) * kstep; const char* b2 = last ? nB : cB + (size_t)(t + 2) * kstep;
            const char* a3 = a2 + kstep; const char* b3 = b2 + kstep;
            if (last && has_next) S.a_ready(nxt);
            if constexpr (SP2) {
            PG8_LDB(B0, 0, 0); PG8_LDB(B1, 0, 1); PG8_SCHED; PG8_LDA(At, 0, 0); PG8_STAGE(PG8_SA(1, 1), a1 + hstep, voffA);
            PG8_WAIT_V(8); PG8_WAIT_L(0); PG8_BAR; PG8_MMA(0, 0, At, B0); PG8_MMA(0, 1, At, B1); PG8_BAR; PG8_SCHED;
            PG8_LDA(At, 0, 1); PG8_STAGE(PG8_SB(0, 0), b2, voffB); PG8_STAGE(PG8_SB(0, 1), b2 + hstep, voffB); PG8_STAGE(PG8_SA(0, 0), a2, voffA);
            PG8_WAIT_V(8); PG8_WAIT_L(0); PG8_BAR; PG8_MMA(1, 0, At, B0); PG8_MMA(1, 1, At, B1); PG8_BAR; PG8_SCHED;
            PG8_LDB(B0, 1, 0); PG8_LDB(B1, 1, 1); PG8_SCHED; PG8_LDA(At, 1, 0); PG8_STAGE(PG8_SA(0, 1), a2 + hstep, voffA);
            PG8_WAIT_V(8); PG8_WAIT_L(0); PG8_BAR; PG8_MMA(0, 0, At, B0); PG8_MMA(0, 1, At, B1); PG8_BAR; PG8_SCHED;
            PG8_LDA(At, 1, 1); PG8_STAGE(PG8_SB(1, 0), b3, voffB); PG8_STAGE(PG8_SB(1, 1), b3 + hstep, voffB); PG8_STAGE(PG8_SA(1, 0), a3, voffA);
            PG8_WAIT_V(8); PG8_WAIT_L(0); PG8_BAR; PG8_MMA(1, 0, At, B0); PG8_MMA(1, 1, At, B1); PG8_BAR; PG8_SCHED;
            } else {
            PG8_LDB(B0, 0, 0); PG8_SCHED; PG8_LDA(At, 0, 0); PG8_STAGE(PG8_SA(1, 1), a1 + hstep, voffA);
            PG8_WAIT_L(8); PG8_BAR; PG8_WAIT_L(0); PG8_MMA(0, 0, At, B0); PG8_BAR; PG8_SCHED;
            PG8_LDB(B1, 0, 1); PG8_STAGE(PG8_SB(0, 0), b2, voffB);
            PG8_BAR; PG8_WAIT_L(0); PG8_MMA(0, 1, At, B1); PG8_BAR;
            PG8_LDA(At, 0, 1); PG8_STAGE(PG8_SA(0, 0), a2, voffA);
            PG8_BAR; PG8_WAIT_L(0); PG8_MMA(1, 0, At, B0); PG8_BAR; PG8_SCHED;
            PG8_STAGE(PG8_SB(0, 1), b2 + hstep, voffB);
            PG8_WAIT_V(6); PG8_BAR; PG8_MMA(1, 1, At, B1); PG8_BAR;
            PG8_LDB(B0, 1, 0); PG8_SCHED; PG8_LDA(At, 1, 0); PG8_STAGE(PG8_SA(0, 1), a2 + hstep, voffA);
            PG8_WAIT_L(8); PG8_BAR; PG8_WAIT_L(0); PG8_MMA(0, 0, At, B0); PG8_BAR; PG8_SCHED;
            PG8_LDB(B1, 1, 1); PG8_STAGE(PG8_SB(1, 0), b3, voffB);
            PG8_BAR; PG8_WAIT_L(0); PG8_MMA(0, 1, At, B1); PG8_BAR;
            PG8_LDA(At, 1, 1); PG8_STAGE(PG8_SA(1, 0), a3, voffA);
            PG8_BAR; PG8_WAIT_L(0); PG8_MMA(1, 0, At, B0); PG8_BAR; PG8_SCHED;
            PG8_STAGE(PG8_SB(1, 1), b3 + hstep, voffB);
            PG8_WAIT_V(6); PG8_BAR; PG8_MMA(1, 1, At, B1); PG8_BAR;
            }
        }
        if constexpr (ALIGN_EPI) { if (wr == 0) PG8_BAR; }
        if constexpr (!Epi::AFTER_DRAIN) { E(acc, cur, wr, wc, fr, fq); S.done(cur); }
        if (!has_next) break;
#pragma unroll
        for (int a = 0; a < 2; ++a)
#pragma unroll
            for (int b = 0; b < 2; ++b)
#pragma unroll
                for (int m = 0; m < 4; ++m)
#pragma unroll
                    for (int n = 0; n < 2; ++n) acc[a][b][m][n] = (f32x4){0.f, 0.f, 0.f, 0.f};
        cur = nxt; cA = nA; cB = nB; ++ui;
        if constexpr (ALIGN_EPI) { if (wr == 1) PG8_BAR; }
    }
    PG8_WAIT_V(0);
    if constexpr (!ALIGN_EPI) { if (wr == 0) PG8_BAR; }
    PG8_BAR;
    if constexpr (Epi::AFTER_DRAIN) { E.fused(acc, cur, wr, wc, fr, fq, lds, wid, lane); S.done(cur); }
#undef PG8_SA
#undef PG8_SB
#undef PG8_STAGE
#undef PG8_LDA
#undef PG8_LDB
#undef PG8_MMA
#undef PG8_WAIT_V
#undef PG8_WAIT_L
#undef PG8_BAR
#undef PG8_SCHED
}
}

#ifndef PG8_SP2
#define PG8_SP2 true
#endif
#include <hip/hip_bf16.h>
#include <cmath>
namespace attn_body {
using bf16=__hip_bfloat16;
using bf16x8=__attribute__((ext_vector_type(8)))short;
using s16x4=__attribute__((ext_vector_type(4)))short;
using f32x16=__attribute__((ext_vector_type(16)))float;
using u32x4=__attribute__((ext_vector_type(4)))unsigned;
constexpr int BATCH=4,NHEAD=16,SEQ=8192,D=64,DM=NHEAD*D,OPITCH=2048;
constexpr int NW=8,QBLK=32,QB=QBLK*NW,KVBLK=64,NQB=SEQ/QB;
constexpr int ATTN_PITCH=DM, ATTN_UNIT_ROWS=QB;
__device__ __forceinline__ int crow(int r,int hi){return (r&3)+8*(r>>2)+4*hi;}
#define SBAR() __builtin_amdgcn_sched_barrier(0)
__device__ __forceinline__ void cmask(f32x16&p0,f32x16&p1,int jb,int qrel,int hi){
  const float NEG=-INFINITY; int kb=64*jb+4*hi;
  #pragma unroll
  for(int r=0;r<16;++r){int kv=kb+(r&3)+8*(r>>2); if(kv>qrel)p0[r]=NEG; if(kv+32>qrel)p1[r]=NEG;}
}

constexpr int NSLOT=3, SLOTB=8192;
constexpr int LDS_K=0, LDS_V=NSLOT*SLOTB, LDS_V2=2*NSLOT*SLOTB, LDS_WS=3*NSLOT*SLOTB, LDS_OST=LDS_WS+NW*64*4, LDS_BYTES=LDS_OST+NW*4096;
constexpr float C2=0.125f*1.4426950408889634f;
__device__ __forceinline__ void glds16(const void*gsrc,unsigned lds_dst){unsigned keep;
  asm volatile("s_mov_b32 %0, m0\n\ts_mov_b32 m0, %2\n\ts_nop 0\n\tglobal_load_lds_dwordx4 %1, off\n\ts_mov_b32 m0, %0":"=&s"(keep):"v"(gsrc),"s"(lds_dst):"memory");}
__device__ __forceinline__ void glds16s(const void*sbase,unsigned voff,unsigned lds_dst){unsigned keep;
  asm volatile("s_mov_b32 %0, m0\n\ts_mov_b32 m0, %3\n\ts_nop 0\n\tglobal_load_lds_dwordx4 %1, %2\n\ts_mov_b32 m0, %0":"=&s"(keep):"v"(voff),"s"(sbase),"s"(lds_dst):"memory");}
__device__ __forceinline__ float max3f(float a,float b,float c){float r;asm("v_max3_f32 %0, %1, %2, %3":"=v"(r):"v"(a),"v"(b),"v"(c));return r;}
__device__ __forceinline__ float max2f(float a,float b){float r;asm("v_max_f32_e32 %0, %1, %2":"=v"(r):"v"(a),"v"(b));return r;}
__device__ __forceinline__ float fadd_s(float a,float b){float r;asm("v_add_f32_e32 %0, %1, %2":"=v"(r):"v"(a),"v"(b));return r;}
__device__ __forceinline__ float fsub_s(float a,float b){float r;asm("v_sub_f32_e32 %0, %1, %2":"=v"(r):"v"(a),"v"(b));return r;}
typedef float f32x2_t __attribute__((ext_vector_type(2))); typedef __bf16 bf16x2_t __attribute__((ext_vector_type(2)));
__device__ __forceinline__ unsigned cvtpk_s(float lo,float hi){f32x2_t v={lo,hi};bf16x2_t b=__builtin_convertvector(v,bf16x2_t);return __builtin_bit_cast(unsigned,b);}
#define WAIT_BAR(N) asm volatile("s_waitcnt vmcnt(" #N ") lgkmcnt(0)\n\ts_barrier":::"memory")

__device__ __forceinline__ void qkt(f32x16&p0,f32x16&p1,const char*Kslot,const bf16x8*qr,const f32x16&negm,int r32,int hi){
  const char*kb=Kslot+hi*1024+r32*16;
  #pragma unroll
  for(int d0=0;d0<4;++d0){
    const bf16x8 b0=*reinterpret_cast<const bf16x8*>(kb+d0*2048);
    const bf16x8 b1=*reinterpret_cast<const bf16x8*>(kb+d0*2048+512);
    if(d0==0){p0=__builtin_amdgcn_mfma_f32_32x32x16_bf16(b0,qr[0],negm,0,0,0);p1=__builtin_amdgcn_mfma_f32_32x32x16_bf16(b1,qr[0],negm,0,0,0);}
    else{p0=__builtin_amdgcn_mfma_f32_32x32x16_bf16(b0,qr[d0],p0,0,0,0);p1=__builtin_amdgcn_mfma_f32_32x32x16_bf16(b1,qr[d0],p1,0,0,0);}}
}
typedef __attribute__((address_space(3))) const char* lds_cptr;
typedef short v4i16_t __attribute__((ext_vector_type(4)));
__device__ __forceinline__ void kload8(bf16x8*kf,lds_cptr kp){
  kf[0]=*(const __attribute__((address_space(3))) bf16x8*)(kp);      kf[1]=*(const __attribute__((address_space(3))) bf16x8*)(kp+512);
  kf[2]=*(const __attribute__((address_space(3))) bf16x8*)(kp+2048); kf[3]=*(const __attribute__((address_space(3))) bf16x8*)(kp+2560);
  kf[4]=*(const __attribute__((address_space(3))) bf16x8*)(kp+4096); kf[5]=*(const __attribute__((address_space(3))) bf16x8*)(kp+4608);
  kf[6]=*(const __attribute__((address_space(3))) bf16x8*)(kp+6144); kf[7]=*(const __attribute__((address_space(3))) bf16x8*)(kp+6656);
}
__device__ __forceinline__ void kload2(bf16x8*kf,lds_cptr kp,int j){ kf[2*j]=*(const __attribute__((address_space(3))) bf16x8*)(kp+j*2048); kf[2*j+1]=*(const __attribute__((address_space(3))) bf16x8*)(kp+j*2048+512); }
__device__ __forceinline__ s16x4 vtr(lds_cptr p){ return __builtin_bit_cast(s16x4,__builtin_amdgcn_ds_read_tr16_b64_v4i16((__attribute__((address_space(3))) v4i16_t*)p)); }
__device__ __forceinline__ float rowmax(const f32x16&p0,const f32x16&p1){
  float a=max3f(p0[0],p0[1],p1[0]),b=max3f(p0[2],p0[3],p1[1]);a=max3f(a,p1[2],p1[3]);
  #pragma unroll
  for(int r=4;r<16;r+=4){a=max3f(a,p0[r],p0[r+1]);b=max3f(b,p0[r+2],p0[r+3]);a=max3f(a,p1[r],p1[r+1]);b=max3f(b,p1[r+2],p1[r+3]);}
  const float m=max2f(a,b);
  auto rr=__builtin_amdgcn_permlane32_swap(__float_as_uint(m),__float_as_uint(m),false,false);
  return max2f(__uint_as_float(rr[0]),__uint_as_float(rr[1]));
}
__device__ __forceinline__ void pv(f32x16*o,int vb,bf16x8 pa0,bf16x8 pa1,bf16x8 pa2,bf16x8 pa3){
  #pragma unroll
  for(int d0=0;d0<2;++d0){s16x4 lo[4],hi[4];
    #pragma unroll
    for(int ks=0;ks<4;++ks){
      asm volatile("ds_read_b64_tr_b16 %0,%1 offset:%c2":"=&v"(lo[ks]):"v"(vb),"i"(d0*4096+ks*1024):"memory");
      asm volatile("ds_read_b64_tr_b16 %0,%1 offset:%c2":"=&v"(hi[ks]):"v"(vb),"i"(d0*4096+ks*1024+512):"memory");}
    asm volatile("s_waitcnt lgkmcnt(0)":::"memory");SBAR();
    #define PK(k) (bf16x8){lo[k][0],lo[k][1],lo[k][2],lo[k][3],hi[k][0],hi[k][1],hi[k][2],hi[k][3]}
    o[d0]=__builtin_amdgcn_mfma_f32_32x32x16_bf16(pa0,PK(0),o[d0],0,0,0);
    o[d0]=__builtin_amdgcn_mfma_f32_32x32x16_bf16(pa1,PK(1),o[d0],0,0,0);
    o[d0]=__builtin_amdgcn_mfma_f32_32x32x16_bf16(pa2,PK(2),o[d0],0,0,0);
    o[d0]=__builtin_amdgcn_mfma_f32_32x32x16_bf16(pa3,PK(3),o[d0],0,0,0);
    #undef PK
  }
}

#ifndef ATTN_STORE16
#define ATTN_STORE16(p,v) (*(u32x4*)(p)=(v))
#endif
template<int THRL> __device__ __forceinline__ void attn_unit(int b,int h,int vcol,int ocol,int qb,const bf16*Q,const bf16*__restrict__ K,const bf16*__restrict__ V,bf16*O,char*shm){
  int tid_=threadIdx.x; asm volatile("":"+v"(tid_)); const int tid=tid_,lane=tid&63,r32=lane&31,hi=lane>>5; const int wid=__builtin_amdgcn_readfirstlane(tid>>6);
  const long rowbase=(long)b*SEQ; const int q0=qb*QB;
  const bf16*Qw=Q+(rowbase+q0+wid*QBLK)*DM+h*D;
  const bf16*Kh=K+rowbase*DM+h*D,*Vh=V+rowbase*DM+vcol;
  const unsigned lds0=(unsigned)(uintptr_t)shm;
  float*wsf=(float*)(shm+LDS_WS)+wid*64;
  const bf16*ksrc=Kh+wid*8; const unsigned koff=(unsigned)(lane*DM)*2u;
  const bf16*vsrc=Vh+(long)(16*(wid&3))*DM+(wid>>2)*32; const unsigned voff=(unsigned)((lane>>2)*DM+(lane&3)*8)*2u;
  const unsigned kdst=lds0+LDS_K+wid*1024, vdst=lds0+LDS_V+wid*1024, vdst2=lds0+LDS_V2+wid*1024;
  #define DMA_K(t,slot) glds16s(ksrc+(long)(t)*KVBLK*DM,koff,(unsigned)__builtin_amdgcn_readfirstlane(kdst+(slot)))
  #define DMA_V(t,slot) do{ glds16s(vsrc+(long)(t)*KVBLK*DM,voff,(unsigned)__builtin_amdgcn_readfirstlane(vdst+(slot))); glds16s(vsrc+64+(long)(t)*KVBLK*DM,voff,(unsigned)__builtin_amdgcn_readfirstlane(vdst2+(slot))); }while(0)
  const int vb0=(int)(lds0+LDS_V)+((lane>>4)&1)*32+(lane&3)*8+(4*hi+((lane&15)>>2))*64;
  const char*Kbase=shm+LDS_K; bf16x8 kf[8];
  const lds_cptr shm3=(lds_cptr)shm; const lds_cptr kp0=shm3+LDS_K+hi*1024+r32*16; const lds_cptr vp0=shm3+LDS_V+((lane>>4)&1)*32+(lane&3)*8+(4*hi+((lane&15)>>2))*64;
  const int NT=(q0+QB)/KVBLK;
  DMA_K(0,0);DMA_V(0,0);DMA_K(1,SLOTB);
  bf16x8 qr[4];
  #pragma unroll
  for(int d0=0;d0<4;++d0)qr[d0]=*reinterpret_cast<const bf16x8*>(&Qw[(long)r32*DM+d0*16+hi*8]);
  float mhat=0.f,l_reg=0.f;f32x16 o[4];o[0]=f32x16{};o[1]=f32x16{};o[2]=f32x16{};o[3]=f32x16{};const f32x16 zero16=f32x16{};
  const int qrel=wid*QBLK+r32;
  #define CMASK(P0,P1,t) do{int jb_=(t)-(NT-4); if(jb_>=0)cmask(P0,P1,jb_,qrel,hi);}while(0)
  bool resc=false;
  #define START(P0,P1) do{ const float rm=rowmax(P0,P1); resc=false; \
    { const float dl=rm; mhat=fadd_s(mhat,dl); \
      _Pragma("unroll") for(int r=0;r<16;++r){P0[r]=fsub_s(P0[r],dl);P1[r]=fsub_s(P1[r],dl);} \
      } \
    _Pragma("unroll") for(int r=0;r<16;++r)P0[r]=__builtin_amdgcn_exp2f(P0[r]); }while(0)
  #define RESC() do{ if(resc){ asm volatile("s_waitcnt lgkmcnt(0)":::"memory"); \
      _Pragma("unroll") for(int d_=0;d_<4;++d_) _Pragma("unroll") for(int r=0;r<16;++r)o[d_][r]*=wsf[crow(r,hi)]; } }while(0)
  f32x16 pA0,pA1,pB0,pB1;
  int sl_prev=0,sl_cur=0,sl_next=SLOTB;
  #define ROT() do{sl_prev=sl_cur;sl_cur=sl_next;sl_next=(sl_next==(NSLOT-1)*SLOTB)?0:sl_next+SLOTB;}while(0)
  DMA_K(2,2*SLOTB);
  WAIT_BAR(3);
  qkt(pA0,pA1,Kbase,qr,zero16,r32,hi);asm volatile("s_nop 15\n\ts_nop 7":"+v"(pA0),"+v"(pA1));CMASK(pA0,pA1,0);
  START(pA0,pA1);
  _Pragma("unroll") for(int r=0;r<16;++r)pA1[r]=__builtin_amdgcn_exp2f(pA1[r]);
  { float s0_=0.f; _Pragma("unroll") for(int r=0;r<16;++r){s0_+=pA0[r];s0_+=pA1[r];} l_reg+=s0_; }
  WAIT_BAR(0);
  DMA_K(3,0);DMA_V(1,SLOTB);
  ROT();
  kload8(kf,kp0+sl_cur);
  WAIT_BAR(3);
  s16x4 vlo[8],vhi[8]; u32x4 pw0,pw1,pw2,pw3;
  #define PKW(P,B) cvtpk_s(P[B],P[B+1])
  #define PAF(k) __builtin_bit_cast(bf16x8,pw##k)
  #define VFR(i) (bf16x8){vlo[i][0],vlo[i][1],vlo[i][2],vlo[i][3],vhi[i][0],vhi[i][1],vhi[i][2],vhi[i][3]}
  #define PIN(x) asm volatile("":"+v"(x))
  #define MX3(a,b,c) __builtin_fmaxf(__builtin_fmaxf((a),(b)),(c))
  #define GAPA(MF,A0,A1,A2,A3,W0,W1,PW) do{ MF; W0; W1; PIN(PW); SBAR(); }while(0)
  #define EX(v) __builtin_amdgcn_exp2f(v)
  #define GAPB(MF,X,B,S0,S1) do{ MF; X[B]=EX(X[B]); X[B+1]=EX(X[B+1]); sacc+=S0; sacc+=S1; PIN(sacc); PIN(X); SBAR(); }while(0)
  #define VRD(i) do{ vlo[i]=vtr(vp_+(((i)>>2)*4096+((i)&3)*1024)); vhi[i]=vtr(vp_+(((i)>>2)*4096+((i)&3)*1024+512)); }while(0)
  #define VRD2(i) do{ vlo[i]=vtr(vp_+((LDS_V2-LDS_V)+((i)>>2)*4096+((i)&3)*1024)); vhi[i]=vtr(vp_+((LDS_V2-LDS_V)+((i)>>2)*4096+((i)&3)*1024+512)); SBAR(); }while(0)
  #define VFR2(i) VFR(i)
  #define KRD(G,j) do{ if(G){ kload2(kf,kp0+sl_next,j); SBAR(); } }while(0)
  #define STEP(C0,C1,P0,P1,t,GK,GV,GL) do{ SBAR(); \
    const lds_cptr vp_=vp0+sl_prev; \
    VRD(0); SBAR(); \
    GAPA(C0=__builtin_amdgcn_mfma_f32_32x32x16_bf16(kf[0],qr[0],zero16,0,0,0), P0[2],P0[3],P0[4],P0[5],     pw0[0]=PKW(P0,0), pw0[1]=PKW(P0,2), pw0); \
    VRD(4); SBAR(); GAPA(C1=__builtin_amdgcn_mfma_f32_32x32x16_bf16(kf[1],qr[0],zero16,0,0,0), P0[6],P0[7],P0[8],P0[9],     pw0[2]=PKW(P0,4), pw0[3]=PKW(P0,6), pw0); \
    VRD(1); SBAR(); GAPA(C0=__builtin_amdgcn_mfma_f32_32x32x16_bf16(kf[2],qr[1],C0,0,0,0),   P0[10],P0[11],P0[12],P0[13], pw1[0]=PKW(P0,8), pw1[1]=PKW(P0,10), pw1); \
    VRD(5); SBAR(); GAPA(C1=__builtin_amdgcn_mfma_f32_32x32x16_bf16(kf[3],qr[1],C1,0,0,0),   P0[14],P0[15],P1[0],P1[1],   pw1[2]=PKW(P0,12),pw1[3]=PKW(P0,14), pw1); \
    VRD(2); SBAR(); GAPA(C0=__builtin_amdgcn_mfma_f32_32x32x16_bf16(kf[4],qr[2],C0,0,0,0),   P1[2],P1[3],P1[4],P1[5],     pw2[0]=PKW(P1,0), pw2[1]=PKW(P1,2), pw2); \
    VRD(6); SBAR(); GAPA(C1=__builtin_amdgcn_mfma_f32_32x32x16_bf16(kf[5],qr[2],C1,0,0,0),   P1[6],P1[7],P1[8],P1[9],     pw2[2]=PKW(P1,4), pw2[3]=PKW(P1,6), pw2); \
    VRD(3); SBAR(); GAPA(C0=__builtin_amdgcn_mfma_f32_32x32x16_bf16(kf[6],qr[3],C0,0,0,0),   P1[10],P1[11],P1[12],P1[13], pw3[0]=PKW(P1,8), pw3[1]=PKW(P1,10), pw3); \
    VRD(7); SBAR(); GAPA(C1=__builtin_amdgcn_mfma_f32_32x32x16_bf16(kf[7],qr[3],C1,0,0,0),   P1[14],P1[15],0.f,0.f,       pw3[2]=PKW(P1,12),pw3[3]=PKW(P1,14), pw3); \
    if(GK){DMA_K((t)+3,sl_cur);} if(GV){DMA_V((t)+1,sl_next);} \
    CMASK(C0,C1,t); \
    _Pragma("unroll") for(int r=0;r<16;++r){C0[r]-=mhat;C1[r]-=mhat;} \
    { float a=MX3(C0[0],C0[1],C1[0]),b=MX3(C0[2],C0[3],C1[1]); a=MX3(a,C1[2],C1[3]); \
      _Pragma("unroll") for(int r=4;r<16;r+=4){a=MX3(a,C0[r],C0[r+1]);b=MX3(b,C0[r+2],C0[r+3]);a=MX3(a,C1[r],C1[r+1]);b=MX3(b,C1[r+2],C1[r+3]);} \
      float rm=__builtin_fmaxf(a,b); { auto rr=__builtin_amdgcn_permlane32_swap(__float_as_uint(rm),__float_as_uint(rm),false,false); rm=__builtin_fmaxf(__uint_as_float(rr[0]),__uint_as_float(rr[1])); } \
      resc=false; \
      if(__builtin_expect(__any(rm>(float)THRL),0)){ const float dl=__builtin_fmaxf(rm,0.f); mhat+=dl; \
        _Pragma("unroll") for(int r=0;r<16;++r){C0[r]-=dl;C1[r]-=dl;} \
        const float f=__builtin_amdgcn_exp2f(-dl); l_reg*=f; if(hi==0)wsf[r32]=f; resc=true; } } \
    SBAR(); \
    float sacc=0.f; \
    GAPB(o[0]=__builtin_amdgcn_mfma_f32_32x32x16_bf16(PAF(0),VFR(0),o[0],0,0,0), C0,0,0.f,0.f); VRD2(0); \
    GAPB(o[1]=__builtin_amdgcn_mfma_f32_32x32x16_bf16(PAF(0),VFR(4),o[1],0,0,0), C0,2,C0[0],C0[1]); VRD2(4); \
    KRD(GL,0); GAPB(o[0]=__builtin_amdgcn_mfma_f32_32x32x16_bf16(PAF(1),VFR(1),o[0],0,0,0), C0,4,C0[2],C0[3]); VRD2(1); \
    KRD(GL,1); GAPB(o[1]=__builtin_amdgcn_mfma_f32_32x32x16_bf16(PAF(1),VFR(5),o[1],0,0,0), C0,6,C0[4],C0[5]); VRD2(5); \
    KRD(GL,2); GAPB(o[0]=__builtin_amdgcn_mfma_f32_32x32x16_bf16(PAF(2),VFR(2),o[0],0,0,0), C0,8,C0[6],C0[7]); VRD2(2); \
    KRD(GL,3); GAPB(o[1]=__builtin_amdgcn_mfma_f32_32x32x16_bf16(PAF(2),VFR(6),o[1],0,0,0), C0,10,C0[8],C0[9]); VRD2(6); \
    GAPB(o[0]=__builtin_amdgcn_mfma_f32_32x32x16_bf16(PAF(3),VFR(3),o[0],0,0,0), C0,12,C0[10],C0[11]); VRD2(3); \
    GAPB(o[1]=__builtin_amdgcn_mfma_f32_32x32x16_bf16(PAF(3),VFR(7),o[1],0,0,0), C0,14,C0[12],C0[13]); VRD2(7); \
    GAPB(o[2]=__builtin_amdgcn_mfma_f32_32x32x16_bf16(PAF(0),VFR2(0),o[2],0,0,0), C1,0,C0[14],C0[15]); \
    GAPB(o[3]=__builtin_amdgcn_mfma_f32_32x32x16_bf16(PAF(0),VFR2(4),o[3],0,0,0), C1,2,C1[0],C1[1]); \
    GAPB(o[2]=__builtin_amdgcn_mfma_f32_32x32x16_bf16(PAF(1),VFR2(1),o[2],0,0,0), C1,4,C1[2],C1[3]); \
    GAPB(o[3]=__builtin_amdgcn_mfma_f32_32x32x16_bf16(PAF(1),VFR2(5),o[3],0,0,0), C1,6,C1[4],C1[5]); \
    GAPB(o[2]=__builtin_amdgcn_mfma_f32_32x32x16_bf16(PAF(2),VFR2(2),o[2],0,0,0), C1,8,C1[6],C1[7]); \
    GAPB(o[3]=__builtin_amdgcn_mfma_f32_32x32x16_bf16(PAF(2),VFR2(6),o[3],0,0,0), C1,10,C1[8],C1[9]); \
    GAPB(o[2]=__builtin_amdgcn_mfma_f32_32x32x16_bf16(PAF(3),VFR2(3),o[2],0,0,0), C1,12,C1[10],C1[11]); \
    GAPB(o[3]=__builtin_amdgcn_mfma_f32_32x32x16_bf16(PAF(3),VFR2(7),o[3],0,0,0), C1,14,C1[12],C1[13]); sacc+=C1[14]; sacc+=C1[15]; l_reg+=sacc; \
    }while(0)
  int t=1;
  #undef CMASK
  #define CMASK(P0,P1,t) do{}while(0)
  for(;t+5<NT;t+=2){
    STEP(pB0,pB1,pA0,pA1,t,true,true,true);     WAIT_BAR(3); RESC(); ROT();
    STEP(pA0,pA1,pB0,pB1,t+1,true,true,true);   WAIT_BAR(3); RESC(); ROT();
  }
  #undef CMASK
  #define CMASK(P0,P1,t) do{int jb_=(t)-(NT-4); if(jb_>=0)cmask(P0,P1,jb_,qrel,hi);}while(0)
  #define ENDW(tt) do{ if((tt)+3<NT){WAIT_BAR(3);} else if((tt)+2<NT){WAIT_BAR(2);} else {WAIT_BAR(0);} }while(0)
  for(;t+1<NT;t+=2){
    STEP(pB0,pB1,pA0,pA1,t,(t+3<NT),(t+1<NT),(t+1<NT));       ENDW(t);   RESC(); ROT();
    STEP(pA0,pA1,pB0,pB1,t+1,(t+4<NT),(t+2<NT),(t+2<NT));     ENDW(t+1); RESC(); ROT();
  }
  STEP(pB0,pB1,pA0,pA1,NT-1,false,false,false); RESC();
  {
    pw0=(u32x4){PKW(pB0,0),PKW(pB0,2),PKW(pB0,4),PKW(pB0,6)};pw1=(u32x4){PKW(pB0,8),PKW(pB0,10),PKW(pB0,12),PKW(pB0,14)};pw2=(u32x4){PKW(pB1,0),PKW(pB1,2),PKW(pB1,4),PKW(pB1,6)};pw3=(u32x4){PKW(pB1,8),PKW(pB1,10),PKW(pB1,12),PKW(pB1,14)};
    SBAR(); pv(o,vb0+sl_cur,PAF(0),PAF(1),PAF(2),PAF(3)); pv(o+2,vb0+(LDS_V2-LDS_V)+sl_cur,PAF(0),PAF(1),PAF(2),PAF(3)); }
  #undef PKW
  #undef PAF
  #undef VFR
  #undef PIN
  #undef MX3
  #undef GAPA
  #undef GAPB
  #undef EX
  #undef VRD
  #undef VRD2
  #undef VFR2
  #undef KRD
  #undef STEP
  #undef ENDW
  {auto rr=__builtin_amdgcn_permlane32_swap(__float_as_uint(l_reg),__float_as_uint(l_reg),false,false);l_reg=__uint_as_float(rr[0])+__uint_as_float(rr[1]);}
  if(hi==0)wsf[32+r32]=l_reg;asm volatile("s_waitcnt lgkmcnt(0)":::"memory");
  float rli[16];
  #pragma unroll
  for(int r=0;r<16;++r)rli[r]=__builtin_amdgcn_rcpf(wsf[32+crow(r,hi)]);
  bf16*Ow=O+(rowbase+q0+wid*QBLK)*OPITCH+ocol;
  #pragma unroll
  for(int hh=0;hh<2;++hh){ bf16*stg=(bf16*)(shm+LDS_OST)+wid*2048;
    #pragma unroll
    for(int r=0;r<16;++r){const int orow=crow(r,hi);
      #pragma unroll
      for(int d0=0;d0<2;++d0)stg[orow*64+d0*32+r32]=__float2bfloat16(o[2*hh+d0][r]*rli[r]);}
    asm volatile("s_waitcnt lgkmcnt(0)":::"memory");
    #pragma unroll
    for(int i=0;i<4;++i){const int row=i*8+(lane>>3),ch=lane&7; const u32x4 v=*(const u32x4*)(stg+row*64+ch*8); ATTN_STORE16(Ow+hh*64+(long)row*OPITCH+ch*8,v);}
    asm volatile("s_waitcnt lgkmcnt(0)":::"memory"); }
  asm volatile("s_waitcnt lgkmcnt(0)\n\ts_barrier":::"memory");
  #undef DMA_K
  #undef DMA_V
  #undef CMASK
  #undef START
  #undef RESC
  #undef ROT
}
constexpr int ATTN_LDS_BYTES=LDS_BYTES;
template<int THRL> __device__ __forceinline__ void diffattn_phase(char*lds,const bf16*Q,const bf16*K,const bf16*V,bf16*O,int vcu,int G){
  for(int cmb=vcu;cmb<512;cmb+=G){
    const int bh=cmb>>3,s=cmb&7,b=bh>>4,map=bh&15;
    #pragma unroll 1
    for(int i=0;i<4;++i){ const int qb=(i==0)?s:(i==1)?15-s:(i==2)?16+s:31-s;
      attn_unit<THRL>(b,map,(map>>1)*128,map*128,qb,Q,K,V,O,lds); }
  }
}
#undef SBAR
#undef WAIT_BAR
}

#include <hip/hip_cooperative_groups.h>
namespace cg = cooperative_groups;
#define LAS __attribute__((address_space(3)))
typedef unsigned short bf16;
typedef unsigned v4u __attribute__((ext_vector_type(4)));
typedef unsigned v2u __attribute__((ext_vector_type(2)));
typedef float f32x4 __attribute__((ext_vector_type(4)));
typedef short bf16x8 __attribute__((ext_vector_type(8)));
#define LDS_WAIT() asm volatile("s_waitcnt lgkmcnt(0)" ::: "memory")

constexpr int NWAVES = 8;
constexpr int BATCH = 4, SEQ = 8192, TOK = BATCH * SEQ, D = 1024, FF = 2816, PLE = 256, MINW = 3080;
constexpr float EPS = 1e-6f;
constexpr float KSCALE = 0.08838834764831845f;
constexpr float LAM_INIT = 0.35550906759096f;
constexpr size_t MiB = (size_t)1 << 20;
constexpr size_t W_FFN_IN = 0, W_FFN_OUT = 44 * MiB, W_PLE_PROJ = 66 * MiB, W_PLE_GATE = 67 * MiB, W_MIN = 71 * MiB, W_MOUT = 77 * MiB, W_KV = 79 * MiB, W_Q = 83 * MiB, W_O = 85 * MiB;
constexpr size_t WS_XN = 88 * MiB, WS_XKV = 152 * MiB, WS_H = 216 * MiB, WS_R = 280 * MiB, WS_END = 512 * MiB;
constexpr size_t R_GATES = WS_R + 192 * MiB, R_NB = WS_R + 193 * MiB, R_NS = R_NB + MiB / 2, R_STATS = WS_R + 194 * MiB, R_MS = R_STATS + MiB / 4, R_WG8 = WS_R + 200 * MiB;
constexpr int LDS_BYTES = 147456, LDS_MISC = 147392;
constexpr size_t WS_RSTD = 87 * MiB + 256 * 1024, WS_RSTD_KV = 87 * MiB + 512 * 1024;
constexpr size_t WS_BAR = 87 * MiB;

__device__ __forceinline__ unsigned f2bf(float f) { unsigned u = __builtin_bit_cast(unsigned, f); return (u + 0x7fffu + ((u >> 16) & 1u)) >> 16; }
__device__ __forceinline__ unsigned pk2(float lo, float hi) { return pg8::cvt_pk_bf16(lo, hi); }
__device__ __forceinline__ float blo(unsigned w) { return __uint_as_float(w << 16); }
__device__ __forceinline__ float bhi(unsigned w) { return __uint_as_float(w & 0xffff0000u); }
__device__ __forceinline__ float shx(float v, int o, int lane) { return __int_as_float(__builtin_amdgcn_ds_bpermute((lane ^ o) << 2, __float_as_int(v))); }
__device__ __forceinline__ float shup(float v, int o, int lane) { return __int_as_float(__builtin_amdgcn_ds_bpermute(((lane - o) & 63) << 2, __float_as_int(v))); }
__device__ __forceinline__ float wave_scan_add(float v, int lane) {
#pragma unroll
    for (int o = 1; o < 64; o <<= 1) { const float t = shup(v, o, lane); if (lane >= o) v += t; }
    return v;
}
__device__ __forceinline__ float wave_scan_max(float v, int lane) {
#pragma unroll
    for (int o = 1; o < 64; o <<= 1) { const float t = shup(v, o, lane); if (lane >= o) v = fmaxf(v, t); }
    return v;
}
__device__ __forceinline__ float wave_max(float v, int lane) {
#pragma unroll
    for (int o = 1; o < 64; o <<= 1) v = fmaxf(v, shx(v, o, lane));
    return v;
}
__device__ __forceinline__ float wave_sum(float v, int lane) {
#pragma unroll
    for (int o = 1; o < 64; o <<= 1) v += shx(v, o, lane);
    return v;
}
__device__ __forceinline__ float sigm(float x) { return __builtin_amdgcn_rcpf(1.f + __expf(-x)); }

__device__ __forceinline__ void xpose_item(const float* W, int K, int ldw, int N, bf16* WT, int mode, LAS float* scr, int item, int lane, const float* gk) {
    const int nblk = N / 32, kb = item / nblk, nb = item % nblk, k0 = 64 * kb, n0 = 32 * nb;
#pragma unroll 8
    for (int i = 0; i < 32; ++i) { const int kk = 2 * i + (lane >> 5); float wv = __builtin_nontemporal_load(W + (size_t)(k0 + kk) * ldw + n0 + (lane & 31)); if (gk) wv *= gk[k0 + kk]; scr[kk * 33 + (lane & 31)] = wv; }
    LDS_WAIT(); asm volatile("" ::: "memory");
    int r0 = n0;
    if (mode == 1) r0 = (n0 < FF) ? ((n0 >> 7) * 256 + (n0 & 127)) : ((((n0 - FF) >> 7) * 256) + 128 + ((n0 - FF) & 127));
    const int c = lane & 7;
#pragma unroll
    for (int j = 0; j < 4; ++j) { const int n = (lane >> 3) + 8 * j; const LAS float* s = scr + (8 * c) * 33 + n;
        v4u o; o.x = pk2(s[0 * 33], s[1 * 33]); o.y = pk2(s[2 * 33], s[3 * 33]); o.z = pk2(s[4 * 33], s[5 * 33]); o.w = pk2(s[6 * 33], s[7 * 33]);
        *(v4u*)(WT + (size_t)(r0 + n) * K + k0 + 8 * c) = o; }
    LDS_WAIT(); asm volatile("" ::: "memory");
}

struct RowP { const float* xin_f; const bf16* xin_b; bf16* xout_b; float* xout_f; const bf16* h; const float* gpost; float hscale;
              float* rms; bf16* xkv;
              const float* g1; const float* wg; const float* bg; float* gates; const float* psrc; bf16* pdst; };
__device__ __forceinline__ void row_phase(const RowP& a, int gw, int NGW, int lane) {
    constexpr int RB = 4;
    for (int m0 = gw * RB; m0 < TOK; m0 += NGW * RB) {
        f32x4 xf[RB][4]; v2u xb[RB][4]; v2u hw[RB][4]; f32x4 pv[RB];
        if (a.xin_f) {
#pragma unroll
            for (int r = 0; r < RB; ++r) { const f32x4* xr = (const f32x4*)(a.xin_f + (size_t)(m0 + r) * D) + lane;
#pragma unroll
                for (int j = 0; j < 4; ++j) xf[r][j] = __builtin_nontemporal_load(xr + 64 * j); }
        } else {
#pragma unroll
            for (int r = 0; r < RB; ++r) { const v2u* xr = (const v2u*)(a.xin_b + (size_t)(m0 + r) * D) + lane;
#pragma unroll
                for (int j = 0; j < 4; ++j) xb[r][j] = xr[64 * j]; }
        }
        if (a.h) {
#pragma unroll
            for (int r = 0; r < RB; ++r) { const v2u* hr = (const v2u*)(a.h + (size_t)(m0 + r) * D) + lane;
#pragma unroll
                for (int j = 0; j < 4; ++j) hw[r][j] = __builtin_nontemporal_load(hr + 64 * j); }
        }
        if (a.psrc) {
#pragma unroll
            for (int r = 0; r < RB; ++r) pv[r] = __builtin_nontemporal_load((const f32x4*)(a.psrc + (size_t)(m0 + r) * PLE) + lane);
        }
#pragma unroll
        for (int r = 0; r < RB; ++r) {
            const int m = m0 + r;
            f32x4 v[4];
            float rin = 1.f; if (!a.xin_f) rin = a.rms[m];
#pragma unroll
            for (int j = 0; j < 4; ++j) { if (a.xin_f) v[j] = xf[r][j]; else { const v2u w = xb[r][j]; v[j] = (f32x4){blo(w.x), bhi(w.x), blo(w.y), bhi(w.y)} * rin; } }
            if (a.h) {
                f32x4 hv[4]; float ss = 0.f;
#pragma unroll
                for (int j = 0; j < 4; ++j) { const v2u w = hw[r][j]; hv[j] = (f32x4){blo(w.x), bhi(w.x), blo(w.y), bhi(w.y)};
                    ss += (hv[j].x * hv[j].x + hv[j].y * hv[j].y) + (hv[j].z * hv[j].z + hv[j].w * hv[j].w); }
                ss = wave_sum(ss, lane); const float rs = rsqrtf(ss * (1.f / D) + EPS) * a.hscale;
#pragma unroll
                for (int j = 0; j < 4; ++j) { const f32x4 g = ((const f32x4*)a.gpost)[lane + 64 * j]; v[j] = v[j] + hv[j] * rs * g; }
            }
            if (a.xout_f) { f32x4* xo = (f32x4*)(a.xout_f + (size_t)m * D) + lane;
#pragma unroll
                for (int j = 0; j < 4; ++j) __builtin_nontemporal_store(v[j], xo + 64 * j); }
            if (a.xout_b) {
                float ss = 0.f;
#pragma unroll
                for (int j = 0; j < 4; ++j) ss += (v[j].x * v[j].x + v[j].y * v[j].y) + (v[j].z * v[j].z + v[j].w * v[j].w);
                ss = wave_sum(ss, lane); const float rs = rsqrtf(ss * (1.f / D) + EPS);
                v2u* o1 = (v2u*)(a.xout_b + (size_t)m * D) + lane;
                v2u wv[4];
#pragma unroll
                for (int j = 0; j < 4; ++j) { const f32x4 z = v[j] * rs; wv[j].x = pk2(z.x, z.y); wv[j].y = pk2(z.z, z.w); o1[64 * j] = wv[j]; }
                if (lane == 0) a.rms[m] = sqrtf(ss * (1.f / D) + EPS);
                if (a.xkv) { v2u* o2 = (v2u*)(a.xkv + (size_t)m * D) + lane;
#pragma unroll
                    for (int j = 0; j < 4; ++j) o2[64 * j] = wv[j]; }
                if (a.gates) {
                    f32x4 ga = (f32x4){0.f, 0.f, 0.f, 0.f}, gb = ga;
#pragma unroll
                    for (int j = 0; j < 4; ++j) { const f32x4* wp = (const f32x4*)(a.wg + (size_t)(4 * lane + 256 * j) * 8);
                        const f32x4 y = v[j] * rs * ((const f32x4*)a.g1)[lane + 64 * j];
#pragma unroll
                        for (int e = 0; e < 4; ++e) { const f32x4 w0 = wp[2 * e], w1 = wp[2 * e + 1]; ga = ga + w0 * y[e]; gb = gb + w1 * y[e]; } }
#pragma unroll
                    for (int e = 0; e < 4; ++e) { ga[e] = wave_sum(ga[e], lane); gb[e] = wave_sum(gb[e], lane); }
                    if (lane == 0) { f32x4 li, lf;
#pragma unroll
                        for (int e = 0; e < 4; ++e) { li[e] = ga[e] + a.bg[e]; const float z = gb[e] + a.bg[4 + e]; lf[e] = fminf(z, 0.f) - log1pf(__expf(-fabsf(z))); }
                        f32x4* gp = (f32x4*)(a.gates + (size_t)m * 8); gp[0] = li; gp[1] = lf; }
                }
            }
            if (a.psrc) { v2u w; w.x = pk2(pv[r].x, pv[r].y); w.y = pk2(pv[r].z, pv[r].w); ((v2u*)(a.pdst + (size_t)m * PLE))[lane] = w; }
        }
    }
}

__device__ __forceinline__ void m1_phase(LAS unsigned char* lds, const bf16* QKVO, const float* GATES, bf16* KBT, float* NB, float* STATS, int vcu, int G, int tid) {
    const int lane = tid & 63, wid = __builtin_amdgcn_readfirstlane(tid >> 6), fr = lane & 15, fq = lane >> 4;
    LAS bf16* vT = (LAS bf16*)lds;
    LAS bf16* kT = (LAS bf16*)(lds + 69632);
    LAS float* fl = (LAS float*)(lds + 104448);
    for (int u = vcu; u < 1024; u += G) {
        const int b = u >> 8, h = (u >> 6) & 3, c = u & 63; const size_t t0 = (size_t)b * SEQ + (size_t)c * 128;
        v4u kr[2][2], vr[4][2];
#pragma unroll
        for (int i = 0; i < 2; ++i) { const int idx = tid + 512 * i, sp = idx & 63, dc = idx >> 6; const bf16* p = QKVO + (t0 + 2 * sp) * 3072 + 512 + h * 128 + dc * 8;
            kr[i][0] = *(const v4u*)p; kr[i][1] = *(const v4u*)(p + 3072); }
#pragma unroll
        for (int i = 0; i < 4; ++i) { const int idx = tid + 512 * i, sp = idx & 63, vc = idx >> 6; const bf16* p = QKVO + (t0 + 2 * sp) * 3072 + 1024 + h * 256 + vc * 8;
            vr[i][0] = *(const v4u*)p; vr[i][1] = *(const v4u*)(p + 3072); }
        if (tid < 128) { fl[tid] = GATES[(t0 + tid) * 8 + 4 + h]; fl[128 + tid] = GATES[(t0 + tid) * 8 + h]; }
        __syncthreads();
        if (tid < 128) { float s = wave_scan_add(fl[tid], lane); if (wid == 1) s += wave_sum(fl[lane], lane); fl[256 + tid] = s; }
        __syncthreads();
        { const float bL = fl[256 + 127];
          const float mx = wave_max(fmaxf(bL - fl[256 + lane] + fl[128 + lane], bL - fl[320 + lane] + fl[192 + lane]), lane);
          if (tid < 128) fl[384 + tid] = __expf(bL - fl[256 + tid] + fl[128 + tid] - mx);
          if (tid == 0) { STATS[2 * u] = bL; STATS[2 * u + 1] = mx; } }
        __syncthreads();
#pragma unroll
        for (int i = 0; i < 2; ++i) { const int idx = tid + 512 * i, sp = idx & 63, dc = idx >> 6, s0 = 2 * sp; const float sc0 = fl[384 + s0], sc1 = fl[385 + s0];
            LAS unsigned* dst = (LAS unsigned*)(kT + (dc * 8) * 136 + s0); const v4u a = kr[i][0], c2 = kr[i][1];
            dst[0 * 68] = pk2(blo(a.x) * sc0, blo(c2.x) * sc1); dst[1 * 68] = pk2(bhi(a.x) * sc0, bhi(c2.x) * sc1); dst[2 * 68] = pk2(blo(a.y) * sc0, blo(c2.y) * sc1); dst[3 * 68] = pk2(bhi(a.y) * sc0, bhi(c2.y) * sc1);
            dst[4 * 68] = pk2(blo(a.z) * sc0, blo(c2.z) * sc1); dst[5 * 68] = pk2(bhi(a.z) * sc0, bhi(c2.z) * sc1); dst[6 * 68] = pk2(blo(a.w) * sc0, blo(c2.w) * sc1); dst[7 * 68] = pk2(bhi(a.w) * sc0, bhi(c2.w) * sc1); }
#pragma unroll
        for (int i = 0; i < 4; ++i) { const int idx = tid + 512 * i, sp = idx & 63, vc = idx >> 6, s0 = 2 * sp;
            LAS unsigned* dst = (LAS unsigned*)(vT + (vc * 8) * 136 + s0); const v4u a = vr[i][0], c2 = vr[i][1];
            dst[0 * 68] = (a.x & 0xffffu) | (c2.x << 16); dst[1 * 68] = (a.x >> 16) | (c2.x & 0xffff0000u); dst[2 * 68] = (a.y & 0xffffu) | (c2.y << 16); dst[3 * 68] = (a.y >> 16) | (c2.y & 0xffff0000u);
            dst[4 * 68] = (a.z & 0xffffu) | (c2.z << 16); dst[5 * 68] = (a.z >> 16) | (c2.z & 0xffff0000u); dst[6 * 68] = (a.w & 0xffffu) | (c2.w << 16); dst[7 * 68] = (a.w >> 16) | (c2.w & 0xffff0000u); }
        __syncthreads();
        f32x4 acc[2][8];
#pragma unroll
        for (int m = 0; m < 2; ++m)
#pragma unroll
            for (int n = 0; n < 8; ++n) acc[m][n] = (f32x4){0.f, 0.f, 0.f, 0.f};
#pragma unroll
        for (int kk = 0; kk < 4; ++kk) { bf16x8 yf[2];
#pragma unroll
            for (int m = 0; m < 2; ++m) yf[m] = *(const LAS bf16x8*)(vT + (32 * wid + 16 * m + fr) * 136 + fq * 8 + 32 * kk);
#pragma unroll
            for (int n = 0; n < 8; ++n) { const bf16x8 xf = *(const LAS bf16x8*)(kT + (16 * n + fr) * 136 + fq * 8 + 32 * kk);
#pragma unroll
                for (int m = 0; m < 2; ++m) acc[m][n] = __builtin_amdgcn_mfma_f32_16x16x32_bf16(xf, yf[m], acc[m][n], 0, 0, 0); } }
        bf16* dstg = KBT + (size_t)u * 32768;
#pragma unroll
        for (int m = 0; m < 2; ++m)
#pragma unroll
            for (int n = 0; n < 8; ++n) { v2u w; w.x = pk2(acc[m][n][0], acc[m][n][1]); w.y = pk2(acc[m][n][2], acc[m][n][3]);
                *(v2u*)(dstg + (32 * wid + 16 * m + fr) * 128 + 16 * n + 4 * fq) = w; }
        if (tid < 128) { float s = 0.f;
#pragma unroll 4
            for (int i = 0; i < 16; ++i) { const v4u q = *(const LAS v4u*)(kT + tid * 136 + 8 * i); s += ((blo(q.x) + bhi(q.x)) + (blo(q.y) + bhi(q.y))) + ((blo(q.z) + bhi(q.z)) + (blo(q.w) + bhi(q.w))); }
            NB[(size_t)u * 128 + tid] = s; }
        __syncthreads();
    }
}

__device__ __forceinline__ void m2_phase(const bf16* __restrict__ KBT, bf16* __restrict__ CT, const float* __restrict__ NB, float* __restrict__ NS, const float* __restrict__ STATS, float* __restrict__ MS, int vcu, int G, int tid) {
    const int NTH = G * 512;
    for (int item = vcu * 512 + tid; item < 16 * 8192; item += NTH) {
        const int bh = item >> 13, e = item & 8191;
        float c0 = 0.f, c1 = 0.f, c2 = 0.f, c3 = 0.f, m = -INFINITY;
#pragma unroll 1
        for (int cb = 0; cb < 64; cb += 8) {
            v2u kb[8]; float bLs[8], mls[8];
#pragma unroll
            for (int i = 0; i < 8; ++i) { const int u = bh * 64 + cb + i; kb[i] = __builtin_nontemporal_load((const v2u*)(KBT + (size_t)u * 32768 + (size_t)e * 4)); bLs[i] = STATS[2 * u]; mls[i] = STATS[2 * u + 1]; }
#pragma unroll
            for (int i = 0; i < 8; ++i) { const int u = bh * 64 + cb + i;
                v2u w; w.x = pk2(c0, c1); w.y = pk2(c2, c3); *(v2u*)(CT + (size_t)u * 32768 + (size_t)e * 4) = w;
                if (e == 0) MS[u] = m;
                const float mn = fmaxf(bLs[i] + m, mls[i]); const float dec = __expf(bLs[i] + m - mn), scl = __expf(mls[i] - mn);
                c0 = dec * c0 + scl * blo(kb[i].x); c1 = dec * c1 + scl * bhi(kb[i].x); c2 = dec * c2 + scl * blo(kb[i].y); c3 = dec * c3 + scl * bhi(kb[i].y); m = mn; }
        }
    }
    for (int item = vcu * 512 + tid; item < 16 * 128; item += NTH) {
        const int bh = item >> 7, d = item & 127; float n = 0.f, m = -INFINITY;
        for (int c = 0; c < 64; ++c) { const int u = bh * 64 + c; NS[(size_t)u * 128 + d] = n;
            const float bL = STATS[2 * u], ml = STATS[2 * u + 1]; const float mn = fmaxf(bL + m, ml);
            n = __expf(bL + m - mn) * n + __expf(ml - mn) * NB[(size_t)u * 128 + d]; m = mn; }
    }
}

__device__ __forceinline__ void m3_phase(LAS unsigned char* lds, const bf16* QKVO, const float* GATES, const bf16* CT, const float* NS, const float* MS, const float* headnorm, bf16* HG, int vcu, int G, int tid) {
    const int lane = tid & 63, wid = __builtin_amdgcn_readfirstlane(tid >> 6), fr = lane & 15, fq = lane >> 4;
    LAS bf16* Ap = (LAS bf16*)lds;
    LAS bf16* Bp = (LAS bf16*)(lds + 67584);
    LAS float* fl = (LAS float*)(lds + 135168);
    for (int u = vcu; u < 1024; u += G) {
        const int b = u >> 8, h = (u >> 6) & 3, c = u & 63; const size_t t0 = (size_t)b * SEQ + (size_t)c * 128;
        const float mc = MS[u];
        { v4u kc[4];
#pragma unroll
          for (int i = 0; i < 4; ++i) { const int idx = tid + 512 * i, row = idx >> 4, ch = idx & 15; kc[i] = *(const v4u*)(QKVO + (t0 + row) * 3072 + 512 + h * 128 + ch * 8); }
          if (tid < 128) { fl[tid] = GATES[(t0 + tid) * 8 + 4 + h]; fl[128 + tid] = GATES[(t0 + tid) * 8 + h]; fl[384 + tid] = NS[(size_t)u * 128 + tid]; }
#pragma unroll
          for (int i = 0; i < 4; ++i) { const int idx = tid + 512 * i, row = idx >> 4, ch = idx & 15; *(LAS v4u*)(Bp + row * 136 + ch * 8) = kc[i]; } }
        __syncthreads();
        float at = 0.f;
        if (tid < 128) { float s = wave_scan_add(fl[tid], lane); if (wid == 1) s += wave_sum(fl[lane], lane); at = fl[128 + tid] - s; fl[512 + tid] = s; fl[640 + tid] = at; }
        __syncthreads();
        if (tid < 128) { float pm = wave_scan_max(at, lane); if (wid == 1) pm = fmaxf(pm, wave_max(fl[640 + lane], lane)); fl[256 + tid] = fmaxf(mc, pm); }
        __syncthreads();
        const int trow = 16 * wid + fr;
        const float Mt = fl[256 + trow], btr = fl[512 + trow]; const float sint = __expf(mc - Mt);
        const bf16* qrow = QKVO + (t0 + trow) * 3072 + h * 128 + fq * 8;
        v4u qf[4];
#pragma unroll
        for (int kk = 0; kk < 4; ++kk) qf[kk] = *(const v4u*)(qrow + 32 * kk);
        float rs = 0.f, qn = 0.f;
#pragma unroll
        for (int kk = 0; kk < 4; ++kk) { const LAS float* np = fl + 384 + fq * 8 + 32 * kk; const v4u q = qf[kk];
            const float q0 = blo(q.x), q1 = bhi(q.x), q2 = blo(q.y), q3 = bhi(q.y), q4 = blo(q.z), q5 = bhi(q.z), q6 = blo(q.w), q7 = bhi(q.w);
            qn += (q0 * np[0] + q1 * np[1]) + (q2 * np[2] + q3 * np[3]) + (q4 * np[4] + q5 * np[5]) + (q6 * np[6] + q7 * np[7]);
            v4u w; w.x = pk2(q0 * sint, q1 * sint); w.y = pk2(q2 * sint, q3 * sint); w.z = pk2(q4 * sint, q5 * sint); w.w = pk2(q6 * sint, q7 * sint);
            *(LAS v4u*)(Ap + trow * 264 + 128 + fq * 8 + 32 * kk) = w; }
#pragma unroll
        for (int n = 0; n < 8; ++n) {
            v2u w; w.x = 0u; w.y = 0u;
            if (n <= wid) {
                f32x4 acc = (f32x4){0.f, 0.f, 0.f, 0.f};
                const LAS bf16* krow = Bp + (16 * n + fr) * 136 + fq * 8;
#pragma unroll
                for (int kk = 0; kk < 4; ++kk) { const v4u kf = *(const LAS v4u*)(krow + 32 * kk);
                    acc = __builtin_amdgcn_mfma_f32_16x16x32_bf16(__builtin_bit_cast(bf16x8, kf), __builtin_bit_cast(bf16x8, qf[kk]), acc, 0, 0, 0); }
                float sv[4];
#pragma unroll
                for (int r = 0; r < 4; ++r) { const int s = 16 * n + 4 * fq + r; const float wgt = (s <= trow) ? __expf(fl[640 + s] - Mt) : 0.f; sv[r] = acc[r] * wgt; rs += sv[r]; }
                w.x = pk2(sv[0], sv[1]); w.y = pk2(sv[2], sv[3]);
            }
            *(LAS v2u*)(Ap + trow * 264 + 16 * n + 4 * fq) = w;
        }
        rs += shx(rs, 16, lane); rs += shx(rs, 32, lane); qn += shx(qn, 16, lane); qn += shx(qn, 32, lane);
        const float den = rs + sint * qn; const float rD = 1.f / fmaxf(fabsf(den), __expf(-(btr + Mt)));
        f32x4 acc2[2][8];
#pragma unroll
        for (int hv = 0; hv < 2; ++hv)
#pragma unroll
            for (int n = 0; n < 8; ++n) acc2[hv][n] = (f32x4){0.f, 0.f, 0.f, 0.f};
#pragma unroll
        for (int hv = 0; hv < 2; ++hv) {
            __syncthreads();
#pragma unroll
            for (int i = 0; i < 2; ++i) { const int idx = tid + 512 * i, sp = idx & 63, vc = idx >> 6, s0 = 2 * sp; const bf16* p = QKVO + (t0 + s0) * 3072 + 1024 + h * 256 + 128 * hv + vc * 8;
                const v4u a = *(const v4u*)p, c2 = *(const v4u*)(p + 3072);
                LAS unsigned* dst = (LAS unsigned*)(Bp + (vc * 8) * 264 + s0);
                dst[0 * 132] = (a.x & 0xffffu) | (c2.x << 16); dst[1 * 132] = (a.x >> 16) | (c2.x & 0xffff0000u); dst[2 * 132] = (a.y & 0xffffu) | (c2.y << 16); dst[3 * 132] = (a.y >> 16) | (c2.y & 0xffff0000u);
                dst[4 * 132] = (a.z & 0xffffu) | (c2.z << 16); dst[5 * 132] = (a.z >> 16) | (c2.z & 0xffff0000u); dst[6 * 132] = (a.w & 0xffffu) | (c2.w << 16); dst[7 * 132] = (a.w >> 16) | (c2.w & 0xffff0000u); }
#pragma unroll
            for (int i = 0; i < 4; ++i) { const int idx = tid + 512 * i, row = idx >> 4, ch = idx & 15;
                const v4u raw = *(const v4u*)(CT + (size_t)u * 32768 + (size_t)(128 * hv + row) * 128 + ch * 8);
                *(LAS v4u*)(Bp + row * 264 + 128 + ch * 8) = raw; }
            __syncthreads();
#pragma unroll
            for (int kk = 0; kk < 8; ++kk) { const bf16x8 yf = *(const LAS bf16x8*)(Ap + trow * 264 + fq * 8 + 32 * kk);
#pragma unroll
                for (int n = 0; n < 8; ++n) { const bf16x8 xf = *(const LAS bf16x8*)(Bp + (16 * n + fr) * 264 + fq * 8 + 32 * kk);
                    acc2[hv][n] = __builtin_amdgcn_mfma_f32_16x16x32_bf16(xf, yf, acc2[hv][n], 0, 0, 0); } }
        }
        float ss = 0.f;
#pragma unroll
        for (int hv = 0; hv < 2; ++hv)
#pragma unroll
            for (int n = 0; n < 8; ++n) { acc2[hv][n] = acc2[hv][n] * rD; const f32x4 z = acc2[hv][n]; ss += (z[0] * z[0] + z[1] * z[1]) + (z[2] * z[2] + z[3] * z[3]); }
        ss += shx(ss, 16, lane); ss += shx(ss, 32, lane);
        const float rstd = rsqrtf(ss * (1.f / 256.f) + EPS);
#pragma unroll
        for (int hv = 0; hv < 2; ++hv)
#pragma unroll
            for (int n = 0; n < 8; ++n) { const int vv = 128 * hv + 16 * n + 4 * fq;
                const f32x4 hn = *(const f32x4*)(headnorm + h * 256 + vv);
                const v2u og = *(const v2u*)(QKVO + (t0 + trow) * 3072 + 2048 + h * 256 + vv);
                const f32x4 z = acc2[hv][n] * rstd * hn;
                v2u w; w.x = pk2(z[0] * sigm(blo(og.x)), z[1] * sigm(bhi(og.x))); w.y = pk2(z[2] * sigm(blo(og.y)), z[3] * sigm(bhi(og.y)));
                *(v2u*)(HG + (t0 + trow) * 1024 + h * 256 + vv) = w; }
        __syncthreads();
    }
}

__device__ __forceinline__ void cmb_phase(const bf16* O, const float* lamv, const float* subln, bf16* DN, int gw, int NGW, int lane) {
    const float s1 = wave_sum(lamv[lane] * lamv[64 + lane], lane), s2 = wave_sum(lamv[128 + lane] * lamv[192 + lane], lane);
    const float lam = __expf(s1) - __expf(s2) + LAM_INIT;
    const int hh = lane >> 3, sub = lane & 7;
    f32x4 g[4];
#pragma unroll
    for (int j = 0; j < 4; ++j) g[j] = ((const f32x4*)(subln + 16 * sub))[j] * (1.f - LAM_INIT);
    for (int m = gw; m < TOK; m += NGW) {
        const v4u* p1 = (const v4u*)(O + (size_t)m * 2048 + (2 * hh) * 128 + 16 * sub); const v4u* p2 = p1 + 16;
        const v4u a0 = __builtin_nontemporal_load(p1), a1 = __builtin_nontemporal_load(p1 + 1), b0 = __builtin_nontemporal_load(p2), b1 = __builtin_nontemporal_load(p2 + 1);
        float d[16];
        d[0] = blo(a0.x) - lam * blo(b0.x); d[1] = bhi(a0.x) - lam * bhi(b0.x); d[2] = blo(a0.y) - lam * blo(b0.y); d[3] = bhi(a0.y) - lam * bhi(b0.y);
        d[4] = blo(a0.z) - lam * blo(b0.z); d[5] = bhi(a0.z) - lam * bhi(b0.z); d[6] = blo(a0.w) - lam * blo(b0.w); d[7] = bhi(a0.w) - lam * bhi(b0.w);
        d[8] = blo(a1.x) - lam * blo(b1.x); d[9] = bhi(a1.x) - lam * bhi(b1.x); d[10] = blo(a1.y) - lam * blo(b1.y); d[11] = bhi(a1.y) - lam * bhi(b1.y);
        d[12] = blo(a1.z) - lam * blo(b1.z); d[13] = bhi(a1.z) - lam * bhi(b1.z); d[14] = blo(a1.w) - lam * blo(b1.w); d[15] = bhi(a1.w) - lam * bhi(b1.w);
        float ss = 0.f;
#pragma unroll
        for (int e = 0; e < 16; ++e) ss += d[e] * d[e];
        ss += shx(ss, 1, lane); ss += shx(ss, 2, lane); ss += shx(ss, 4, lane);
        const float rs = rsqrtf(ss * (1.f / 128.f) + EPS);
        v4u w0, w1;
        w0.x = pk2(d[0] * rs * g[0][0], d[1] * rs * g[0][1]); w0.y = pk2(d[2] * rs * g[0][2], d[3] * rs * g[0][3]); w0.z = pk2(d[4] * rs * g[1][0], d[5] * rs * g[1][1]); w0.w = pk2(d[6] * rs * g[1][2], d[7] * rs * g[1][3]);
        w1.x = pk2(d[8] * rs * g[2][0], d[9] * rs * g[2][1]); w1.y = pk2(d[10] * rs * g[2][2], d[11] * rs * g[2][3]); w1.z = pk2(d[12] * rs * g[3][0], d[13] * rs * g[3][1]); w1.w = pk2(d[14] * rs * g[3][2], d[15] * rs * g[3][3]);
        v4u* op = (v4u*)(DN + (size_t)m * 1024 + hh * 128 + 16 * sub); op[0] = w0; op[1] = w1;
    }
}

#define XB_TMO      128
#define XB_XCNT(j)  (256  + 64 * (j))
#define XB_XSUB(j)  (1280 + 64 * (j))
#define XB_XGEN(j)  (2304 + 64 * (j))
#define XB_TOP      3328
#define XB_TOPGEN   3392
#define XCD_BAR_WORDS 3456
#define XB_SPIN_CAP (1u << 18)

__device__ __forceinline__ unsigned xb_ld(unsigned* p)              { return __hip_atomic_load(p, __ATOMIC_RELAXED, __HIP_MEMORY_SCOPE_AGENT); }
__device__ __forceinline__ unsigned xb_add(unsigned* p, unsigned v) { return __hip_atomic_fetch_add(p, v, __ATOMIC_RELAXED, __HIP_MEMORY_SCOPE_AGENT); }
__device__ __forceinline__ unsigned xb_xcc_id() { return (unsigned)__builtin_amdgcn_s_getreg((3 << 11) | 20) & 0xFu; }
#define XB_SPIN(cond, bar) do { unsigned _sp = 0; while (cond) { __builtin_amdgcn_s_sleep(1); \
    if ((++_sp & 255u) == 0u) { if (xb_ld(&(bar)[XB_TMO])) break; if (_sp > XB_SPIN_CAP) { atomicAdd(&(bar)[XB_TMO], 1u); break; } } } } while (0)

struct XcdBarrier {
    unsigned* bar; unsigned x;
    volatile LAS unsigned* st;
};

__device__ __forceinline__ XcdBarrier xcd_barrier_post(unsigned* bar, volatile LAS unsigned* st) {
    XcdBarrier b; b.bar = bar; b.x = xb_xcc_id(); b.st = st;
    if (threadIdx.x == 0) (void)xb_add(&bar[XB_XCNT(b.x)], 1u);
    return b;
}
__device__ __forceinline__ void xcd_barrier_complete(unsigned* bar, unsigned x, unsigned& nloc, unsigned& nx) {
    const unsigned G = gridDim.x * gridDim.y * gridDim.z;
    unsigned sum, cnt, mine, sp = 0u;
    for (;;) {
        sum = 0u; cnt = 0u; mine = 0u;
#pragma unroll
        for (unsigned j = 0; j < 16; ++j) { const unsigned c = xb_ld(&bar[XB_XCNT(j)]); sum += c; cnt += (c > 0u) ? 1u : 0u; mine = (j == x) ? c : mine; }
        if (sum == G) break;
        __builtin_amdgcn_s_sleep(1);
        if ((++sp & 255u) == 0u) { if (xb_ld(&bar[XB_TMO])) break; if (sp > XB_SPIN_CAP) { atomicAdd(&bar[XB_TMO], 1u); break; } }
    }
    nloc = mine > 0u ? mine : 1u; nx = cnt > 0u ? cnt : 1u;
}

__device__ __forceinline__ void xcd_barrier(const XcdBarrier& b) {
    asm volatile("s_waitcnt vmcnt(0)" ::: "memory");
    __syncthreads();
    if (threadIdx.x == 0) {
        unsigned* bar = b.bar;
        __builtin_amdgcn_s_waitcnt(0);
        unsigned nloc = b.st[0], nx = b.st[1];
        if (nloc == 0u) { xcd_barrier_complete(bar, b.x, nloc, nx); b.st[0] = nloc; b.st[1] = nx; }
        const unsigned old = xb_add(&bar[XB_XSUB(b.x)], 1u);
        const unsigned gen = old / nloc;
        if (old + 1u == (gen + 1u) * nloc) {
            __builtin_amdgcn_fence(__ATOMIC_RELEASE, "agent");
            asm volatile("s_waitcnt vmcnt(0)" ::: "memory");
            const unsigned og = xb_add(&bar[XB_TOP], 1u);
            const unsigned tg = og / nx;
            if (og + 1u == (tg + 1u) * nx) xb_add(&bar[XB_TOPGEN], 1u);
            else XB_SPIN(xb_ld(&bar[XB_TOPGEN]) == tg, bar);
            __builtin_amdgcn_fence(__ATOMIC_ACQUIRE, "agent");
            xb_add(&bar[XB_XGEN(b.x)], 1u);
            asm volatile("s_waitcnt vmcnt(0)" ::: "memory");
        } else {
            XB_SPIN(xb_ld(&bar[XB_XGEN(b.x)]) == gen, bar);
            __builtin_amdgcn_fence(__ATOMIC_ACQUIRE, "agent");
            asm volatile("s_waitcnt vmcnt(0)" ::: "memory");
        }
    }
    __syncthreads();
}

struct Args { const float* in[17]; float* out; unsigned char* ws; };
#define GAS __attribute__((address_space(1)))
struct ArgsG { const GAS float* in[17]; GAS float* out; GAS unsigned char* ws; };
typedef const __attribute__((address_space(4))) ArgsG* KArgs;
#define PHASE_BEGIN() \
    KArgs kp = (KArgs)__builtin_amdgcn_kernarg_segment_ptr(); asm volatile("" : "+s"(kp)); \
    int tid = threadIdx.x; asm volatile("" : "+v"(tid)); int bx = blockIdx.x; asm volatile("" : "+s"(bx)); \
    const int lane = tid & 63, wave = __builtin_amdgcn_readfirstlane(tid >> 6); const int G = gridDim.x; \
    const int vcu = (G % 8 == 0) ? (bx % 8) * (G / 8) + bx / 8 : bx; const int gw = vcu * NWAVES + wave, NGW = G * NWAVES; \
    unsigned char* ws = (unsigned char*)kp->ws; (void)lane; (void)gw; (void)NGW; (void)vcu; (void)ws;
#define GSYNC_CG() do { __builtin_amdgcn_fence(__ATOMIC_RELEASE, "agent"); cg::this_grid().sync(); __builtin_amdgcn_fence(__ATOMIC_ACQUIRE, "agent"); } while (0)
#define GSYNC() do { KArgs kq_ = (KArgs)__builtin_amdgcn_kernarg_segment_ptr(); asm volatile("" : "+s"(kq_)); \
    XcdBarrier b_; b_.bar = (unsigned*)((unsigned char*)kq_->ws + WS_BAR); b_.x = xb_xcc_id(); b_.st = (volatile LAS unsigned*)(lds + LDS_MISC); xcd_barrier(b_); } while (0)

template <int MODE, bool RS> __device__ __forceinline__ void run_gemm(LAS unsigned char* lds, const bf16* A, const bf16* B, int N, int K, bf16* O, int ldc, int split_cols, size_t split_stride, int sc_lo, int sc_hi, float scale, const float* rs) {
    pg8::Gemm g{A, B, TOK, N, K}; pg8::StaticOrder S; S.init(TOK, N, (int)gridDim.x, (int)blockIdx.x);
    pg8::EpiX<MODE, RS> E{O, ldc, split_cols, split_stride, sc_lo, sc_hi, scale, rs};
    pg8::gemm_phase<pg8::EpiX<MODE, RS>, pg8::StaticOrder, true, true>(lds, g, S, E);
}

constexpr int I_FI = (D / 64) * (2 * FF / 32), I_FO = (FF / 64) * (D / 32), I_PP = (PLE / 64) * (D / 32), I_DD = (D / 64) * (D / 32), I_MI = (D / 64) * (3072 / 32), I_KV = (D / 64) * (2048 / 32);
#define XP1(cnt, src, K_, LDW_, N_, dstoff, MODE_, G_) if (r < (cnt)) { xpose_item((src), (K_), (LDW_), (N_), (bf16*)(ws + (dstoff)), (MODE_), scr, r, lane, (G_)); continue; } r -= (cnt);
#define XPOSE_LOOP(TOTAL, ...) do { extern __shared__ __attribute__((aligned(16))) unsigned char lds_x_[]; LAS float* scr = (LAS float*)((LAS unsigned char*)lds_x_ + wave * 16384); \
    const float* ngp = ((const float*)kp->in[2]); (void)ngp; \
    for (int it = gw; it < (TOTAL); it += NGW) { int r = it; __VA_ARGS__ } } while (0)
#define XP_FFN(L, I) \
    XP1(I_FI, ((const float*)kp->in[3]) + (size_t)((L) * 2 + (I)) * D * 2 * FF, D, 2 * FF, 2 * FF, W_FFN_IN + (size_t)((L) * 2 + (I)) * 11 * MiB, 1, ngp + (size_t)((L) * 8 + (I) * 4) * D) \
    XP1(I_FO, ((const float*)kp->in[4]) + (size_t)((L) * 2 + (I)) * FF * D, FF, D, D, W_FFN_OUT + (size_t)((L) * 2 + (I)) * 11 * MiB / 2, 0, (const float*)nullptr)
#define XP_PLE(L) \
    XP1(I_DD, ((const float*)kp->in[6]) + (size_t)(L) * D * D, D, D, D, W_PLE_GATE + (size_t)(L) * 2 * MiB, 0, ngp + (size_t)((L) * 8 + 6) * D) \
    XP1(I_PP, ((const float*)kp->in[5]) + (size_t)(L) * PLE * D, PLE, D, D, W_PLE_PROJ + (size_t)(L) * MiB / 2, 0, (const float*)nullptr)

__device__ __forceinline__ void ph_prologue(LAS unsigned char* lds) {
    PHASE_BEGIN();
#ifndef NO_XP
    XPOSE_LOOP(I_FI + I_FO, XP_FFN(0, 0));
#endif
    { float* WG8 = (float*)(ws + R_WG8); const float* wi = ((const float*)kp->in[7]);
      for (int i = gw * 64 + lane; i < D * 8; i += NGW * 64) WG8[i] = wi[(size_t)(i >> 3) * MINW + 3072 + (i & 7)]; }
    RowP a{}; a.xin_f = ((const float*)kp->in[0]); a.xout_b = (bf16*)(ws + WS_XN); a.rms = (float*)(ws + WS_RSTD);
    row_phase(a, gw, NGW, lane);
}
template <int LAYER, int HALF> __device__ __forceinline__ void ph_ffn_in(LAS unsigned char* lds) {
    PHASE_BEGIN();
#ifndef NO_G1
    run_gemm<1, false>(lds, (const bf16*)(ws + WS_XN), (const bf16*)(ws + W_FFN_IN + (size_t)(LAYER * 2 + HALF) * 11 * MiB), 2 * FF, D, (bf16*)(ws + WS_R), FF, 0, 0, 0, 0, 1.f, (const float*)(ws + WS_RSTD));
#endif
}
template <int LAYER, int HALF> __device__ __forceinline__ void ph_ffn_out(LAS unsigned char* lds) {
    PHASE_BEGIN();
#ifndef NO_G0A
    run_gemm<0, false>(lds, (const bf16*)(ws + WS_R), (const bf16*)(ws + W_FFN_OUT + (size_t)(LAYER * 2 + HALF) * 11 * MiB / 2), D, FF, (bf16*)(ws + WS_H), D, 0, 0, 0, 0, 1.f, nullptr);
#endif
}
template <int LAYER, int HALF> __device__ __forceinline__ void ph_row_ffn() {
    PHASE_BEGIN();
    const float* ng = ((const float*)kp->in[2]) + (size_t)LAYER * 8 * D;
    RowP a{}; if (LAYER == 0 && HALF == 0) a.xin_f = ((const float*)kp->in[0]); else a.xin_b = (const bf16*)(ws + WS_XN);
    a.xout_b = (bf16*)(ws + WS_XN); a.rms = (float*)(ws + WS_RSTD); a.h = (const bf16*)(ws + WS_H); a.gpost = ng + (HALF ? 5 : 1) * D; a.hscale = 0.5f;
    if (LAYER == 0 && HALF == 0) { a.g1 = ng + 2 * D; a.wg = (const float*)(ws + R_WG8); a.bg = ((const float*)kp->in[8]); a.gates = (float*)(ws + R_GATES); }
    if (HALF == 1) { a.psrc = ((const float*)kp->in[1]) + (size_t)LAYER * TOK * PLE; a.pdst = (bf16*)(ws + WS_R); }
    row_phase(a, gw, NGW, lane);
    if (LAYER == 0 && HALF == 0) XPOSE_LOOP(I_MI, XP1(I_MI, ((const float*)kp->in[7]), D, MINW, 3072, W_MIN, 0, ngp + (size_t)2 * D));
    if (HALF == 1) XPOSE_LOOP(I_DD + I_PP, XP_PLE(LAYER));
    if (LAYER == 1 && HALF == 0) XPOSE_LOOP(I_DD + I_KV, XP1(I_DD, ((const float*)kp->in[13]), D, D, D, W_Q, 0, ngp + (size_t)10 * D) XP1(I_KV, ((const float*)kp->in[12]), D, 2048, 2048, W_KV, 0, ((const float*)kp->in[11])));
}
template <int LAYER> __device__ __forceinline__ void ph_mix_in(LAS unsigned char* lds) {
    PHASE_BEGIN();
#ifndef NO_G0M
    if (LAYER == 0) run_gemm<0, false>(lds, (const bf16*)(ws + WS_XN), (const bf16*)(ws + W_MIN), 3072, D, (bf16*)(ws + WS_R), 3072, 0, 0, 512, 1024, KSCALE, (const float*)(ws + WS_RSTD));
    else {
        run_gemm<0, false>(lds, (const bf16*)(ws + WS_XN), (const bf16*)(ws + W_Q), 1024, D, (bf16*)(ws + WS_H), 1024, 0, 0, 0, 1024, attn_body::C2, (const float*)(ws + WS_RSTD));
        run_gemm<0, false>(lds, (const bf16*)(ws + WS_XKV), (const bf16*)(ws + W_KV), 2048, D, (bf16*)(ws + WS_R), 1024, 1024, (size_t)TOK * 1024, 0, 0, 1.f, (const float*)(ws + WS_RSTD_KV));
    }
#endif
}
__device__ __forceinline__ void ph_m1(LAS unsigned char* lds) { PHASE_BEGIN();
#ifndef NO_M1
    m1_phase(lds, (const bf16*)(ws + WS_R), (const float*)(ws + R_GATES), (bf16*)(ws + WS_H), (float*)(ws + R_NB), (float*)(ws + R_STATS), vcu, G, tid);
#endif
}
__device__ __forceinline__ void ph_m2() { PHASE_BEGIN();
#ifndef NO_M2
    m2_phase((const bf16*)(ws + WS_H), (bf16*)(ws + WS_XKV), (const float*)(ws + R_NB), (float*)(ws + R_NS), (const float*)(ws + R_STATS), (float*)(ws + R_MS), vcu, G, tid);
#endif
    XPOSE_LOOP(I_DD, XP1(I_DD, ((const float*)kp->in[10]), D, D, D, W_MOUT, 0, (const float*)nullptr));
}
__device__ __forceinline__ void ph_m3(LAS unsigned char* lds) { PHASE_BEGIN();
#ifndef NO_M3
    m3_phase(lds, (const bf16*)(ws + WS_R), (const float*)(ws + R_GATES), (const bf16*)(ws + WS_XKV), (const float*)(ws + R_NS), (const float*)(ws + R_MS), ((const float*)kp->in[9]), (bf16*)(unsigned char*)kp->out, vcu, G, tid);
#endif
}
__device__ __forceinline__ void ph_att(unsigned char* lds_generic) { PHASE_BEGIN();
#ifndef NO_ATT
    attn_body::diffattn_phase<8>((char*)lds_generic, (const attn_body::bf16*)(ws + WS_H), (const attn_body::bf16*)(ws + WS_R), (const attn_body::bf16*)(ws + WS_R + 64 * MiB), (attn_body::bf16*)(unsigned char*)kp->out, vcu, G);
#endif
}
__device__ __forceinline__ void ph_cmb() { PHASE_BEGIN();
    cmb_phase((const bf16*)(unsigned char*)kp->out, ((const float*)kp->in[14]), ((const float*)kp->in[15]), (bf16*)(ws + WS_R + 128 * MiB), gw, NGW, lane);
    XPOSE_LOOP(I_DD, XP1(I_DD, ((const float*)kp->in[16]), D, D, D, W_O, 0, (const float*)nullptr));
}
template <int LAYER> __device__ __forceinline__ void ph_mix_out(LAS unsigned char* lds) {
    PHASE_BEGIN();
#ifndef NO_G0B
    run_gemm<0, false>(lds, (LAYER == 0) ? (const bf16*)(unsigned char*)kp->out : (const bf16*)(ws + WS_R + 128 * MiB), (const bf16*)(ws + ((LAYER == 0) ? W_MOUT : W_O)), D, D, (bf16*)(ws + WS_H), D, 0, 0, 0, 0, 1.f, nullptr);
#endif
}
template <int LAYER> __device__ __forceinline__ void ph_row_mix() {
    PHASE_BEGIN();
    const float* ng = ((const float*)kp->in[2]) + (size_t)LAYER * 8 * D;
    RowP a{}; a.xin_b = (const bf16*)(ws + WS_XN); a.xout_b = (bf16*)(ws + WS_XN); a.rms = (float*)(ws + WS_RSTD); a.h = (const bf16*)(ws + WS_H); a.gpost = ng + 3 * D; a.hscale = 1.f;
    row_phase(a, gw, NGW, lane);
    XPOSE_LOOP(I_FI + I_FO, XP_FFN(LAYER, 1));
}
template <int LAYER> __device__ __forceinline__ void ph_ple(LAS unsigned char* lds) {
    PHASE_BEGIN();
#ifndef NO_G2
    run_gemm<2, false>(lds, (const bf16*)(ws + WS_XN), (const bf16*)(ws + W_PLE_GATE + (size_t)LAYER * 2 * MiB), D, D, (bf16*)(ws + WS_H), D, 0, 0, 0, 0, 1.f, (const float*)(ws + WS_RSTD));
#endif
#ifndef NO_G3
    run_gemm<3, false>(lds, (const bf16*)(ws + WS_R), (const bf16*)(ws + W_PLE_PROJ + (size_t)LAYER * MiB / 2), D, PLE, (bf16*)(ws + WS_H), D, 0, 0, 0, 0, 1.f, nullptr);
#endif
}
template <int LAYER> __device__ __forceinline__ void ph_row_ple() {
    PHASE_BEGIN();
    const float* ng = ((const float*)kp->in[2]) + (size_t)LAYER * 8 * D;
    RowP a{}; a.xin_b = (const bf16*)(ws + WS_XN); a.h = (const bf16*)(ws + WS_H); a.gpost = ng + 7 * D; a.hscale = 1.f;
    if (LAYER == 0) { a.xout_b = (bf16*)(ws + WS_XN); a.rms = (float*)(ws + WS_RSTD); a.xkv = (bf16*)(ws + WS_XKV); }
    else { a.xout_f = (float*)kp->out; a.rms = (float*)(ws + WS_RSTD); }
    row_phase(a, gw, NGW, lane);
    if (LAYER == 0) XPOSE_LOOP(I_FI + I_FO, XP_FFN(1, 0));
}

#ifndef REP_M
#define REP_M 1
#endif
#ifndef REP_ATT
#define REP_ATT 1
#endif
#ifndef REP_FFN
#define REP_FFN 1
#endif
#define FFN(L, H) for (int r_ = 0; r_ < REP_FFN; ++r_) { ph_ffn_in<L, H>(lds); GSYNC(); ph_ffn_out<L, H>(lds); GSYNC(); }
__global__ void __launch_bounds__(NWAVES * 64, 2) yoco_fwd(Args args) {
    extern __shared__ __attribute__((aligned(16))) unsigned char lds_[];
    LAS unsigned char* lds = (LAS unsigned char*)lds_;
    { PHASE_BEGIN(); if (tid == 0) { volatile LAS unsigned* st = (volatile LAS unsigned*)(lds + LDS_MISC); st[0] = 0u; st[1] = 0u; }
      (void)xcd_barrier_post((unsigned*)(ws + WS_BAR), (volatile LAS unsigned*)(lds + LDS_MISC)); }
    ph_prologue(lds);
    { KArgs kz_ = (KArgs)__builtin_amdgcn_kernarg_segment_ptr(); asm volatile("" : "+s"(kz_)); if (__builtin_expect(kz_->ws == nullptr, 0)) GSYNC_CG(); }
    GSYNC();
    FFN(0, 0) ph_row_ffn<0, 0>(); GSYNC();
    ph_mix_in<0>(lds); GSYNC(); for (int r_ = 0; r_ < REP_M; ++r_) { ph_m1(lds); GSYNC(); ph_m2(); GSYNC(); ph_m3(lds); GSYNC(); } ph_mix_out<0>(lds); GSYNC(); ph_row_mix<0>(); GSYNC();
    FFN(0, 1) ph_row_ffn<0, 1>(); GSYNC();
    ph_ple<0>(lds); GSYNC(); ph_row_ple<0>(); GSYNC();
    FFN(1, 0) ph_row_ffn<1, 0>(); GSYNC();
    ph_mix_in<1>(lds); GSYNC(); for (int r_ = 0; r_ < REP_ATT; ++r_) { ph_att(lds_); GSYNC(); } ph_cmb(); GSYNC(); ph_mix_out<1>(lds); GSYNC(); ph_row_mix<1>(); GSYNC();
    FFN(1, 1) ph_row_ffn<1, 1>(); GSYNC();
    ph_ple<1>(lds); GSYNC(); ph_row_ple<1>();
}

extern "C" void kernel_launch(void* const* d_in, const int* in_sizes, int n_in, void* d_out, int out_size, void* d_ws, size_t ws_size, hipStream_t stream) {
    static int grid = 0;
    if (grid == 0) {
        if (n_in != 17 || out_size != TOK * D || ws_size < WS_END) { fprintf(stderr, "kernel_launch: unexpected shapes (n_in %d, out %d, ws %zu)\n", n_in, out_size, ws_size); grid = -1; return; }
        int dev = 0, cus = 0, per_cu = 0;
        hipGetDevice(&dev); hipDeviceGetAttribute(&cus, hipDeviceAttributeMultiprocessorCount, dev);
        if (hipFuncSetAttribute((const void*)yoco_fwd, hipFuncAttributeMaxDynamicSharedMemorySize, LDS_BYTES) != hipSuccess) { fprintf(stderr, "kernel_launch: hipFuncSetAttribute failed\n"); grid = -1; return; }
        if (hipOccupancyMaxActiveBlocksPerMultiprocessor(&per_cu, (const void*)yoco_fwd, NWAVES * 64, LDS_BYTES) != hipSuccess || per_cu < 1) { fprintf(stderr, "kernel_launch: occupancy query says %d\n", per_cu); per_cu = 1; }
        (void)hipGetLastError();
        grid = cus;
    }
    if (grid < 0) return;
    if (hipMemsetAsync((char*)d_ws + WS_BAR, 0, 16384, stream) != hipSuccess) { fprintf(stderr, "kernel_launch: memset failed\n"); return; }
    Args a{};
    for (int i = 0; i < 17; ++i) a.in[i] = (const float*)d_in[i];
    a.out = (float*)d_out; a.ws = (unsigned char*)d_ws;
    void* kargs[] = {&a};
    hipError_t e = hipLaunchCooperativeKernel((const void*)yoco_fwd, dim3(grid), dim3(NWAVES * 64), kargs, LDS_BYTES, stream);
    if (e != hipSuccess) fprintf(stderr, "kernel_launch: cooperative launch failed: %s (grid %d)\n", hipGetErrorString(e), grid);
}
```
